# Optimizing an MI355X kernel written in HIP

```python
import math
import jax
import jax.numpy as jnp
from jax import lax
import numpy as np

D_MODEL = 1024
BATCH = 8
SEQ = 2048
DEPTH = 2

DEEPNORM_ALPHA = (2 * DEPTH) ** 0.25
DEEPNORM_BETA = (8 * DEPTH) ** -0.25
LN_EPS = 1e-5
CONV_K = 4

GLA_HEADS = 4
GLA_DK = 64
GLA_DV = 128
GLA_QK = GLA_HEADS * GLA_DK
GLA_VW = GLA_HEADS * GLA_DV
GLA_GK_RANK = 16
GLA_GATE_NORM = 16.0
GLA_CHUNK = 64
GLA_NORM_EPS = 1e-5

LRU_WIDTH = 512
LRU_BLOCKS = 8
LRU_BLOCK = LRU_WIDTH // LRU_BLOCKS
LRU_C = 8.0

EVEN_SPLITS = (GLA_QK, GLA_QK, GLA_VW, GLA_VW, GLA_GK_RANK, LRU_WIDTH, LRU_WIDTH)
EVEN_IN = sum(EVEN_SPLITS)
EVEN_MIX = GLA_VW + LRU_WIDTH

SSD_HEADS = 16
SSD_HEADDIM = 64
SSD_INNER = SSD_HEADS * SSD_HEADDIM
SSD_GROUPS = 2
SSD_HEADS_PER_GROUP = SSD_HEADS // SSD_GROUPS
SSD_STATE = 128
SSD_CHUNK = 64
SSD_XBC = SSD_INNER + 2 * SSD_GROUPS * SSD_STATE
SSD_NORM_EPS = 1e-5

RWKV_HEADS = 8
RWKV_HEADDIM = 64
RWKV_WIDTH = RWKV_HEADS * RWKV_HEADDIM
RWKV_DECAY_LORA = 64
RWKV_AAA_LORA = 64
RWKV_GATE_LORA = 128
RWKV_GN_EPS = 64e-5
RWKV_SPLITS = (RWKV_WIDTH, RWKV_WIDTH, RWKV_WIDTH, RWKV_DECAY_LORA, RWKV_AAA_LORA, RWKV_GATE_LORA)
RWKV_IN = sum(RWKV_SPLITS)

ODD_SPLITS = (SSD_INNER, SSD_XBC, SSD_HEADS, RWKV_IN)
ODD_IN = sum(ODD_SPLITS)
ODD_MIX = SSD_INNER + RWKV_WIDTH

FFN_DENSE = 2816
N_EXPERTS = 8
TOP_K = 2
FFN_EXPERT = 3584

kernel_name = 'hybrid_gla_rglru_ssd_rwkv7_moe'


def split_cols(p, sizes):
    return jnp.split(p, np.cumsum(sizes)[:-1].tolist(), axis=-1)


def layer_norm(x, g, b):
    xf = x.astype(jnp.float32)
    mu = jnp.mean(xf, axis=-1, keepdims=True)
    var = jnp.mean(jnp.square(xf - mu), axis=-1, keepdims=True)
    return ((xf - mu) * lax.rsqrt(var + LN_EPS) * g + b).astype(x.dtype)


def rms_norm(x, w, eps):
    xf = x.astype(jnp.float32)
    return xf * lax.rsqrt(jnp.mean(jnp.square(xf), axis=-1, keepdims=True) + eps) * w


def causal_dwconv(x, w, b):
    y = lax.conv_general_dilated(
        x.astype(jnp.float32), w.astype(jnp.float32)[:, None, :],
        window_strides=(1,), padding=[(w.shape[0] - 1, 0)],
        dimension_numbers=('NWC', 'WIO', 'NWC'), feature_group_count=x.shape[-1])
    return y + b


def token_shift(p):
    return jnp.pad(p[:, :-1], ((0, 0), (1, 0), (0, 0)))


def scan_chunks(decay, local):
    def step(s, du):
        d, u = du
        return d * s + u, s
    _, prev = lax.scan(step, jnp.zeros_like(local[0]), (decay, local))
    return prev


def gla_mixer(q, k, v, gk, g, norm_w):
    bsz, t, _ = q.shape
    n = t // GLA_CHUNK

    def heads(z, d):
        return z.astype(jnp.float32).reshape(bsz, n, GLA_CHUNK, GLA_HEADS, d).transpose(0, 3, 1, 2, 4)

    q = heads(q, GLA_DK) * GLA_DK ** -0.5
    k = heads(k, GLA_DK)
    v = heads(v, GLA_DV)
    b = jnp.cumsum(heads(gk, GLA_DK), axis=3)
    b_last = b[:, :, :, -1:, :]
    qd = q * jnp.exp(b)
    att = jnp.einsum('bhncd,bhnmd->bhncm', qd, k * jnp.exp(-b))
    causal = jnp.tril(jnp.ones((GLA_CHUNK, GLA_CHUNK), dtype=bool))
    att = jnp.where(causal, att, 0.0)
    o = jnp.einsum('bhncm,bhnmv->bhncv', att, v)
    local = jnp.einsum('bhncd,bhncv->bhndv', k * jnp.exp(b_last - b), v)
    decay = jnp.exp(b_last[:, :, :, 0, :])[..., None]
    prev = jnp.moveaxis(scan_chunks(jnp.moveaxis(decay, 2, 0), jnp.moveaxis(local, 2, 0)), 0, 2)
    o = o + jnp.einsum('bhncd,bhndv->bhncv', qd, prev)
    o = o.transpose(0, 2, 3, 1, 4).reshape(bsz, t, GLA_HEADS, GLA_DV)
    o = rms_norm(o, norm_w, GLA_NORM_EPS)
    g = g.astype(jnp.float32).reshape(bsz, t, GLA_HEADS, GLA_DV)
    return (o * jax.nn.silu(g)).reshape(bsz, t, GLA_VW)


def rglru_mixer(xb, gate, conv_w, conv_b, wa, ba, wx, bx, lam):
    bsz, t, _ = xb.shape
    xc = causal_dwconv(xb, conv_w, conv_b)
    xblk = xc.reshape(bsz, t, LRU_BLOCKS, LRU_BLOCK)
    r = jax.nn.sigmoid(jnp.einsum('btni,nij->btnj', xblk, wa).reshape(bsz, t, LRU_WIDTH) + ba)
    i = jax.nn.sigmoid(jnp.einsum('btni,nij->btnj', xblk, wx).reshape(bsz, t, LRU_WIDTH) + bx)
    log_a = -LRU_C * r * jax.nn.softplus(-lam)
    a = jnp.exp(log_a)
    u = jnp.sqrt(-jnp.expm1(2.0 * log_a)) * (i * xc)

    def combine(lhs, rhs):
        a1, b1 = lhs
        a2, b2 = rhs
        return a1 * a2, a2 * b1 + b2

    _, h = lax.associative_scan(combine, (a, u), axis=1)
    return h * jax.nn.gelu(gate.astype(jnp.float32))


def ssd_mixer(z, xbc, dt, conv_w, conv_b, dt_bias, a_log, d_skip, norm_w):
    bsz, t, _ = z.shape
    n, l, g, hg, p, s = t // SSD_CHUNK, SSD_CHUNK, SSD_GROUPS, SSD_HEADS_PER_GROUP, SSD_HEADDIM, SSD_STATE
    xbc = jax.nn.silu(causal_dwconv(xbc, conv_w, conv_b))
    xs, bm, cm = split_cols(xbc, (SSD_INNER, g * s, g * s))
    x = xs.reshape(bsz, n, l, g, hg, p)
    bm = bm.reshape(bsz, n, l, g, s)
    cm = cm.reshape(bsz, n, l, g, s)
    dtc = jax.nn.softplus(dt.astype(jnp.float32) + dt_bias).reshape(bsz, n, l, g, hg)
    a = -jnp.exp(a_log.astype(jnp.float32)).reshape(g, hg)
    xdt = x * dtc[..., None]
    acs = jnp.cumsum(dtc * a, axis=2)
    seg = acs[:, :, :, None] - acs[:, :, None, :]
    causal = jnp.tril(jnp.ones((l, l), dtype=bool))[:, :, None, None]
    lmat = jnp.exp(jnp.where(causal, seg, -jnp.inf))
    cb = jnp.einsum('bnlgs,bnmgs->bnlmg', cm, bm)
    y = jnp.einsum('bnlmg,bnlmgh,bnmghp->bnlghp', cb, lmat, xdt)
    decay_states = jnp.exp(acs[:, :, -1:] - acs)
    local = jnp.einsum('bnlgs,bnlgh,bnlghp->bnghps', bm, decay_states, xdt)
    chunk_decay = jnp.exp(acs[:, :, -1])[..., None, None]
    prev = jnp.moveaxis(scan_chunks(jnp.moveaxis(chunk_decay, 1, 0), jnp.moveaxis(local, 1, 0)), 0, 1)
    y = y + jnp.einsum('bnlgs,bnghps,bnlgh->bnlghp', cm, prev, jnp.exp(acs))
    y = y + x * d_skip.reshape(g, hg)[..., None]
    y = y.reshape(bsz, t, SSD_INNER) * jax.nn.silu(z.astype(jnp.float32))
    y = rms_norm(y.reshape(bsz, t, g, SSD_INNER // g), norm_w.reshape(g, SSD_INNER // g), SSD_NORM_EPS)
    return y.reshape(bsz, t, SSD_INNER)


def wkv7_scan(r, w, k, v, a, b):
    def step(st, inp):
        r_t, w_t, k_t, v_t, a_t, b_t = inp
        sa = jnp.einsum('bhvk,bhk->bhv', st, a_t)
        st = st * w_t[:, :, None, :] + sa[..., None] * b_t[:, :, None, :] + v_t[..., None] * k_t[:, :, None, :]
        return st, jnp.einsum('bhvk,bhk->bhv', st, r_t)
    bsz, _, h, nd = r.shape
    s0 = jnp.zeros((bsz, h, nd, nd), jnp.float32)
    _, y = lax.scan(step, s0, tuple(jnp.moveaxis(z, 1, 0) for z in (r, w, k, v, a, b)))
    return jnp.moveaxis(y, 0, 1)


def rwkv7_mixer(p, mu, w0, w2, a0, a2, g2, k_k, k_a, r_k, ln_g, ln_b):
    bsz, t, _ = p.shape
    p = p.astype(jnp.float32)
    p = p + (token_shift(p) - p) * mu
    r, k, v, xw, xa, xg = split_cols(p, RWKV_SPLITS)
    w_log = -jax.nn.softplus(-(w0 + jnp.tanh(xw) @ w2)) - 0.5
    decay = jnp.exp(-jnp.exp(w_log))
    a = jax.nn.sigmoid(a0 + xa @ a2)
    g = jax.nn.sigmoid(xg) @ g2

    def heads(z):
        return z.reshape(bsz, t, RWKV_HEADS, RWKV_HEADDIM)

    kk = heads(k * k_k)
    kk = kk / jnp.maximum(jnp.sqrt(jnp.sum(jnp.square(kk), axis=-1, keepdims=True)), 1e-12)
    k = k * (1.0 + (a - 1.0) * k_a)
    r, k, v, decay, a = heads(r), heads(k), heads(v), heads(decay), heads(a)
    y = wkv7_scan(r, decay, k, v, -kk, kk * a)
    mu_y = jnp.mean(y, axis=-1, keepdims=True)
    var_y = jnp.mean(jnp.square(y - mu_y), axis=-1, keepdims=True)
    y = ((y - mu_y) * lax.rsqrt(var_y + RWKV_GN_EPS)).reshape(bsz, t, RWKV_WIDTH) * ln_g + ln_b
    bonus = (jnp.sum(r * k * r_k, axis=-1, keepdims=True) * v).reshape(bsz, t, RWKV_WIDTH)
    return (y + bonus) * g


def swiglu(x, w1, w3, w2):
    return (jax.nn.silu(x @ w1) * (x @ w3)) @ w2


def moe_swiglu(x, router, w1, w3, w2):
    bsz, t, d = x.shape
    xt = x.reshape(bsz * t, d)
    logits = (xt @ router).astype(jnp.float32)
    top_v, top_i = lax.top_k(logits, TOP_K)
    top_w = jax.nn.softmax(top_v, axis=-1)
    gates = jnp.sum(jax.nn.one_hot(top_i, N_EXPERTS, dtype=jnp.float32) * top_w[..., None], axis=1)
    out = jnp.zeros((bsz * t, d), jnp.float32)
    for e in range(N_EXPERTS):
        out = out + gates[:, e:e + 1] * swiglu(xt, w1[e], w3[e], w2[e])
    return out.reshape(bsz, t, d)


def even_layer(x, w_in, gk_w2, gk_b, gla_norm, conv_w, conv_b, wa, ba, wx, bx, lam,
               w_out, ln1_g, ln1_b, f_w1, f_w3, f_w2, ln2_g, ln2_b):
    p = x @ w_in
    q, k, v, g, gk_lr, xb, gate = split_cols(p, EVEN_SPLITS)
    gk = jax.nn.log_sigmoid((gk_lr @ gk_w2 + gk_b).astype(jnp.float32)) / GLA_GATE_NORM
    y_a = gla_mixer(q, k, v, gk, g, gla_norm)
    y_b = rglru_mixer(xb, gate, conv_w, conv_b, wa, ba, wx, bx, lam)
    mix = jnp.concatenate([y_a, y_b], axis=-1) @ w_out
    x = layer_norm(DEEPNORM_ALPHA * x + mix, ln1_g, ln1_b)
    x = layer_norm(DEEPNORM_ALPHA * x + swiglu(x, f_w1, f_w3, f_w2), ln2_g, ln2_b)
    return x


def odd_layer(x, w_in, conv_w, conv_b, dt_bias, a_log, d_skip, ssd_norm,
              mu, w0, w2, a0, a2, g2, k_k, k_a, r_k, rln_g, rln_b,
              w_out, ln1_g, ln1_b, router, ew1, ew3, ew2, ln2_g, ln2_b):
    p = x @ w_in
    z, xbc, dt, prw = split_cols(p, ODD_SPLITS)
    y_c = ssd_mixer(z, xbc, dt, conv_w, conv_b, dt_bias, a_log, d_skip, ssd_norm)
    y_d = rwkv7_mixer(prw, mu, w0, w2, a0, a2, g2, k_k, k_a, r_k, rln_g, rln_b)
    mix = jnp.concatenate([y_c, y_d], axis=-1) @ w_out
    x = layer_norm(DEEPNORM_ALPHA * x + mix, ln1_g, ln1_b)
    x = layer_norm(DEEPNORM_ALPHA * x + moe_swiglu(x, router, ew1, ew3, ew2), ln2_g, ln2_b)
    return x


def setup_inputs(seed: int = 0) -> dict:
    key = jax.random.key(seed)
    keys = iter(jax.random.split(key, 64))
    ne = (DEPTH + 1) // 2
    no = DEPTH // 2
    f32 = jnp.float32

    def nrm(shape, scale):
        return jax.random.normal(next(keys), shape, f32) * scale

    def unif(shape, lo, hi):
        return jax.random.uniform(next(keys), shape, f32, lo, hi)

    def gain(shape):
        return 1.0 + nrm(shape, 0.02)

    lru_a = unif((ne, LRU_WIDTH), 0.9, 0.999) ** (1.0 / LRU_C)
    dt0 = jnp.exp(unif((no, SSD_HEADS), math.log(1e-3), math.log(1e-1)))
    return {
        'x': nrm((BATCH, SEQ, D_MODEL), 1.0),
        'e_w_in': nrm((ne, D_MODEL, EVEN_IN), D_MODEL ** -0.5),
        'e_gk_w2': nrm((ne, GLA_GK_RANK, GLA_QK), GLA_GK_RANK ** -0.5),
        'e_gk_b': nrm((ne, GLA_QK), 0.1),
        'e_gla_norm': gain((ne, GLA_DV)),
        'e_conv_w': nrm((ne, CONV_K, LRU_WIDTH), CONV_K ** -0.5),
        'e_conv_b': nrm((ne, LRU_WIDTH), 0.1),
        'e_lru_wa': nrm((ne, LRU_BLOCKS, LRU_BLOCK, LRU_BLOCK), LRU_BLOCK ** -0.5),
        'e_lru_ba': nrm((ne, LRU_WIDTH), 0.1),
        'e_lru_wx': nrm((ne, LRU_BLOCKS, LRU_BLOCK, LRU_BLOCK), LRU_BLOCK ** -0.5),
        'e_lru_bx': nrm((ne, LRU_WIDTH), 0.1),
        'e_lru_lambda': jnp.log(lru_a) - jnp.log1p(-lru_a),
        'e_w_out': nrm((ne, EVEN_MIX, D_MODEL), EVEN_MIX ** -0.5 * DEEPNORM_BETA),
        'e_ln1_g': gain((ne, D_MODEL)),
        'e_ln1_b': nrm((ne, D_MODEL), 0.02),
        'e_ffn_w1': nrm((ne, D_MODEL, FFN_DENSE), D_MODEL ** -0.5),
        'e_ffn_w3': nrm((ne, D_MODEL, FFN_DENSE), D_MODEL ** -0.5),
        'e_ffn_w2': nrm((ne, FFN_DENSE, D_MODEL), FFN_DENSE ** -0.5 * DEEPNORM_BETA),
        'e_ln2_g': gain((ne, D_MODEL)),
        'e_ln2_b': nrm((ne, D_MODEL), 0.02),
        'o_w_in': nrm((no, D_MODEL, ODD_IN), D_MODEL ** -0.5),
        'o_conv_w': nrm((no, CONV_K, SSD_XBC), CONV_K ** -0.5),
        'o_conv_b': nrm((no, SSD_XBC), 0.1),
        'o_dt_bias': dt0 + jnp.log(-jnp.expm1(-dt0)),
        'o_a_log': jnp.log(unif((no, SSD_HEADS), 1.0, 16.0)),
        'o_d_skip': 1.0 + nrm((no, SSD_HEADS), 0.1),
        'o_ssd_norm': gain((no, SSD_INNER)),
        'o_rwkv_mu': unif((no, RWKV_IN), 0.0, 1.0),
        'o_rwkv_w0': unif((no, RWKV_WIDTH), -5.0, 0.0),
        'o_rwkv_w2': nrm((no, RWKV_DECAY_LORA, RWKV_WIDTH), 0.5 * RWKV_DECAY_LORA ** -0.5),
        'o_rwkv_a0': nrm((no, RWKV_WIDTH), 0.1),
        'o_rwkv_a2': nrm((no, RWKV_AAA_LORA, RWKV_WIDTH), 0.5 * RWKV_AAA_LORA ** -0.5),
        'o_rwkv_g2': nrm((no, RWKV_GATE_LORA, RWKV_WIDTH), RWKV_GATE_LORA ** -0.5),
        'o_rwkv_k_k': 0.85 + nrm((no, RWKV_WIDTH), 0.05),
        'o_rwkv_k_a': 1.0 + nrm((no, RWKV_WIDTH), 0.05),
        'o_rwkv_r_k': nrm((no, RWKV_HEADS, RWKV_HEADDIM), 0.1),
        'o_rwkv_ln_g': gain((no, RWKV_WIDTH)),
        'o_rwkv_ln_b': nrm((no, RWKV_WIDTH), 0.02),
        'o_w_out': nrm((no, ODD_MIX, D_MODEL), ODD_MIX ** -0.5 * DEEPNORM_BETA),
        'o_ln1_g': gain((no, D_MODEL)),
        'o_ln1_b': nrm((no, D_MODEL), 0.02),
        'o_router': nrm((no, D_MODEL, N_EXPERTS), D_MODEL ** -0.5),
        'o_exp_w1': nrm((no, N_EXPERTS, D_MODEL, FFN_EXPERT), D_MODEL ** -0.5),
        'o_exp_w3': nrm((no, N_EXPERTS, D_MODEL, FFN_EXPERT), D_MODEL ** -0.5),
        'o_exp_w2': nrm((no, N_EXPERTS, FFN_EXPERT, D_MODEL), FFN_EXPERT ** -0.5 * DEEPNORM_BETA),
        'o_ln2_g': gain((no, D_MODEL)),
        'o_ln2_b': nrm((no, D_MODEL), 0.02),
    }


def reference(x, e_w_in, e_gk_w2, e_gk_b, e_gla_norm, e_conv_w, e_conv_b, e_lru_wa, e_lru_ba,
              e_lru_wx, e_lru_bx, e_lru_lambda, e_w_out, e_ln1_g, e_ln1_b, e_ffn_w1, e_ffn_w3,
              e_ffn_w2, e_ln2_g, e_ln2_b, o_w_in, o_conv_w, o_conv_b, o_dt_bias, o_a_log, o_d_skip,
              o_ssd_norm, o_rwkv_mu, o_rwkv_w0, o_rwkv_w2, o_rwkv_a0, o_rwkv_a2, o_rwkv_g2,
              o_rwkv_k_k, o_rwkv_k_a, o_rwkv_r_k, o_rwkv_ln_g, o_rwkv_ln_b, o_w_out, o_ln1_g,
              o_ln1_b, o_router, o_exp_w1, o_exp_w3, o_exp_w2, o_ln2_g, o_ln2_b):
    for i in range(DEPTH):
        j = i // 2
        if i % 2 == 0:
            x = even_layer(x, e_w_in[j], e_gk_w2[j], e_gk_b[j], e_gla_norm[j], e_conv_w[j], e_conv_b[j],
                           e_lru_wa[j], e_lru_ba[j], e_lru_wx[j], e_lru_bx[j], e_lru_lambda[j],
                           e_w_out[j], e_ln1_g[j], e_ln1_b[j], e_ffn_w1[j], e_ffn_w3[j], e_ffn_w2[j],
                           e_ln2_g[j], e_ln2_b[j])
        else:
            x = odd_layer(x, o_w_in[j], o_conv_w[j], o_conv_b[j], o_dt_bias[j], o_a_log[j], o_d_skip[j],
                          o_ssd_norm[j], o_rwkv_mu[j], o_rwkv_w0[j], o_rwkv_w2[j], o_rwkv_a0[j],
                          o_rwkv_a2[j], o_rwkv_g2[j], o_rwkv_k_k[j], o_rwkv_k_a[j], o_rwkv_r_k[j],
                          o_rwkv_ln_g[j], o_rwkv_ln_b[j], o_w_out[j], o_ln1_g[j], o_ln1_b[j],
                          o_router[j], o_exp_w1[j], o_exp_w3[j], o_exp_w2[j], o_ln2_g[j], o_ln2_b[j])
    return x
```

```cpp
#include <hip/hip_runtime.h>
#include <cstdio>
#include <cstdint>
#include <cmath>
namespace pg8 {
#define PG8_LAS __attribute__((address_space(3)))
typedef unsigned short bf16_t;
typedef short bf16x8 __attribute__((ext_vector_type(8)));
typedef float f32x4 __attribute__((ext_vector_type(4)));
typedef unsigned u32x4 __attribute__((ext_vector_type(4)));
constexpr int BM = 256, BK = 64, HALF = 128, HTB = HALF * BK * 2  , STAGE_BYTES = 8 * HTB, NXCD = 8, WGM = 8;

__host__ __device__ __forceinline__ int lds_byte(int r, int c) { const int st = (r >> 4) * 2 + (c >> 5), rr = r & 15, cc = c & 31, ob = rr * 64 + cc * 2; return st * 1024 + (ob ^ (((ob >> 9) & 1) << 5)); }
__host__ __device__ __forceinline__ void stage_rc(int b, int& R, int& C) { const int st = b / 1024, sb = b % 1024, swz = sb ^ (((sb >> 9) & 1) << 5); R = (st >> 1) * 16 + swz / 64; C = (st & 1) * 32 + (swz % 64) / 2; }
__host__ __device__ __forceinline__ int perm32(int rho) { const int n = rho >> 4, i = rho & 15; return 8 * (i >> 2) + 4 * n + (i & 3); }

struct Unit { int pm, pn, om, on; };
struct Gemm { const bf16_t* A; const bf16_t* Bt; int M, N, K; };

struct StaticOrder {
    int nM, nN, nwg, G, c;
    __host__ __device__ void init(int M, int N, int G_, int c_) { nM = M / BM; nN = N / BM; nwg = nM * nN; G = G_; c = c_; }
    __host__ __device__ bool next(int i, Unit& u) const {
        const long L = (long)i * G + c; if (L >= nwg) return false;
        int wgid = (int)L; { const int q = nwg / NXCD, r = nwg % NXCD, xcd = wgid % NXCD, off = wgid / NXCD; wgid = (xcd < r ? xcd * (q + 1) : r * (q + 1) + (xcd - r) * q) + off; }
        const int nig = WGM * nN, gid = wgid / nig, fm = gid * WGM, gsz = (nM - fm) < WGM ? (nM - fm) : WGM;
        u.pm = fm + ((wgid % nig) % gsz); u.pn = (wgid % nig) / gsz; u.om = u.pm; u.on = u.pn; return true;
    }
    __device__ __forceinline__ void a_ready(const Unit&) const {}
    __device__ __forceinline__ void done(const Unit&) const {}
};
struct MoeUpOrder {
    int start, count, pbase; const PG8_LAS int* pe;
    __device__ __forceinline__ bool next(int i, Unit& u) const { if (i >= count) return false; const int k = start + i, pl = k / 28, j = k - pl * 28, p = pbase + pl, e = pe[p];
        u.pm = p; u.pn = e * 28 + j; u.om = pl; u.on = j; return true; }
    __device__ __forceinline__ void a_ready(const Unit&) const {}
    __device__ __forceinline__ void done(const Unit&) const {}
};
struct MoeDownOrder {
    int start, count, pbase; const PG8_LAS int* pe;
    __device__ __forceinline__ bool next(int i, Unit& u) const { if (i >= count) return false; const int d = start + i, pl = d >> 2, j = d & 3, p = pbase + pl, e = pe[p];
        u.pm = pl; u.pn = e * 4 + j; u.om = p; u.on = j; return true; }
    __device__ __forceinline__ void a_ready(const Unit&) const {}
    __device__ __forceinline__ void done(const Unit&) const {}
};

__device__ __forceinline__ unsigned cvt_pk_bf16(float lo, float hi) { unsigned r; asm volatile("v_cvt_pk_bf16_f32 %0, %1, %2" : "=v"(r) : "v"(lo), "v"(hi)); return r; }

struct EpiStoreF32 {
    static constexpr bool PERM = false, AFTER_DRAIN = false;
    float* C; int ldc;
    __device__ __forceinline__ void operator()(const f32x4 (&acc)[2][2][4][2], const Unit& u, int wr, int wc, int fr, int fq) const {
        const int row0 = u.om * BM + wr * 64 + fr, col0 = u.on * BM + wc * 32 + 4 * fq;
#pragma unroll
        for (int ai = 0; ai < 2; ++ai)
#pragma unroll
            for (int m = 0; m < 4; ++m) { float* rowp = C + (size_t)(row0 + ai * HALF + m * 16) * ldc + col0;
#pragma unroll
                for (int bj = 0; bj < 2; ++bj)
#pragma unroll
                    for (int n = 0; n < 2; ++n) *(f32x4*)(rowp + bj * HALF + n * 16) = acc[ai][bj][m][n]; }
    }
};
struct EpiStoreBf16 {
    static constexpr bool PERM = true, AFTER_DRAIN = false;
    bf16_t* O; int ldc;
    __device__ __forceinline__ void operator()(const f32x4 (&acc)[2][2][4][2], const Unit& u, int wr, int wc, int fr, int fq) const {
        const int row0 = u.om * BM + wr * 64 + fr, col0 = u.on * BM + wc * 32 + 8 * fq;
#pragma unroll
        for (int ai = 0; ai < 2; ++ai)
#pragma unroll
            for (int m = 0; m < 4; ++m) { bf16_t* rowp = O + (size_t)(row0 + ai * HALF + m * 16) * ldc + col0;
#pragma unroll
                for (int bj = 0; bj < 2; ++bj) { const f32x4 v0 = acc[ai][bj][m][0], v1 = acc[ai][bj][m][1];
                    u32x4 w; w.x = cvt_pk_bf16(v0[0], v0[1]); w.y = cvt_pk_bf16(v0[2], v0[3]); w.z = cvt_pk_bf16(v1[0], v1[1]); w.w = cvt_pk_bf16(v1[2], v1[3]);
                    *(u32x4*)(rowp + bj * HALF) = w; } }
    }
};
__device__ __forceinline__ float silu_f(float x) { return x * __builtin_amdgcn_rcpf(1.0f + __builtin_amdgcn_exp2f(-1.4426950408889634f * x)); }
struct EpiSwiGLU {
    static constexpr bool PERM = true, AFTER_DRAIN = false;
    bf16_t* O; int ldc;
    __device__ __forceinline__ void operator()(const f32x4 (&acc)[2][2][4][2], const Unit& u, int wr, int wc, int fr, int fq) const {
        const int row0 = u.om * BM + wr * 64 + fr, col0 = u.on * HALF + wc * 32 + 8 * fq;
#pragma unroll
        for (int ai = 0; ai < 2; ++ai)
#pragma unroll
            for (int m = 0; m < 4; ++m) { bf16_t* rowp = O + (size_t)(row0 + ai * HALF + m * 16) * ldc + col0;
                const f32x4 g0 = acc[ai][0][m][0], g1 = acc[ai][0][m][1], u0 = acc[ai][1][m][0], u1 = acc[ai][1][m][1];
                u32x4 w; w.x = cvt_pk_bf16(silu_f(g0[0]) * u0[0], silu_f(g0[1]) * u0[1]); w.y = cvt_pk_bf16(silu_f(g0[2]) * u0[2], silu_f(g0[3]) * u0[3]);
                w.z = cvt_pk_bf16(silu_f(g1[0]) * u1[0], silu_f(g1[1]) * u1[1]); w.w = cvt_pk_bf16(silu_f(g1[2]) * u1[2], silu_f(g1[3]) * u1[3]);
                *(u32x4*)rowp = w; }
    }
};

template <class Epi, class Sched, bool ALIGN_EPI = false, bool SP2 = false>
__device__ __forceinline__ void gemm_phase(PG8_LAS unsigned char* lds, const Gemm g, const Sched& S, const Epi& E) {
    const int tid = threadIdx.x, wid = __builtin_amdgcn_readfirstlane(tid >> 6), lane = tid & 63, wr = wid >> 2, wc = wid & 3, fr = lane & 15, fq = lane >> 4;
    const int K = g.K, nt = K / BK;
    unsigned voffA[2], voffB[2];
#pragma unroll
    for (int i = 0; i < 2; ++i) { int R, C; stage_rc(tid * 16 + i * 8192, R, C); const int Rb = Epi::PERM ? ((R & ~31) + perm32(R & 31)) : R;
        voffA[i] = (unsigned)(R * K + C) * 2u; voffB[i] = (unsigned)(Rb * K + C) * 2u; }
    const size_t kstep = (size_t)(BK * 2);
    const size_t hstep = (size_t)HALF * K * 2;
    const size_t tstep = 2 * hstep;
    const unsigned ldsw = (unsigned)wid * 1024u;
    const int aoff = lds_byte(wr * 64 + fr, fq * 8), boff = lds_byte(wc * 32 + fr, fq * 8);
#define PG8_SA(b, h) (((b) * 2 + (h)) * HTB)
#define PG8_SB(b, h) ((4 + (b) * 2 + (h)) * HTB)
#define PG8_STAGE(bufoff, gbase, voff) do { _Pragma("unroll") for (int _i = 0; _i < 2; ++_i) \
        __builtin_amdgcn_global_load_lds((const unsigned*)((const char*)(gbase) + (voff)[_i]), (PG8_LAS unsigned*)(lds + (bufoff) + ldsw + _i * 8192), 16, 0, 0); } while (0)
#define PG8_LDA(dst, b, h) do { _Pragma("unroll") for (int m = 0; m < 4; ++m) _Pragma("unroll") for (int k = 0; k < 2; ++k) dst[m][k] = *(const PG8_LAS bf16x8*)(lds + PG8_SA(b, h) + aoff + m * 2048 + k * 1024); } while (0)
#define PG8_LDB(dst, b, h) do { _Pragma("unroll") for (int n = 0; n < 2; ++n) _Pragma("unroll") for (int k = 0; k < 2; ++k) dst[n][k] = *(const PG8_LAS bf16x8*)(lds + PG8_SB(b, h) + boff + n * 2048 + k * 1024); } while (0)
#define PG8_MMA(ai, bj, At, Bt) do { __builtin_amdgcn_s_setprio(1); _Pragma("unroll") for (int m = 0; m < 4; ++m) _Pragma("unroll") for (int n = 0; n < 2; ++n) _Pragma("unroll") for (int k = 0; k < 2; ++k) \
        acc[ai][bj][m][n] = __builtin_amdgcn_mfma_f32_16x16x32_bf16(Bt[n][k], At[m][k], acc[ai][bj][m][n], 0, 0, 0); __builtin_amdgcn_s_setprio(0); } while (0)
#define PG8_WAIT_V(n) asm volatile("s_waitcnt vmcnt(" #n ")" ::: "memory")
#define PG8_WAIT_L(n) asm volatile("s_waitcnt lgkmcnt(" #n ")" ::: "memory")
#define PG8_BAR __builtin_amdgcn_s_barrier()
#define PG8_SCHED __builtin_amdgcn_sched_barrier(0)
    Unit cur, nxt; int ui = 0;
    if (!S.next(0, cur)) return;
    f32x4 acc[2][2][4][2];
#pragma unroll
    for (int a = 0; a < 2; ++a)
#pragma unroll
        for (int b = 0; b < 2; ++b)
#pragma unroll
            for (int m = 0; m < 4; ++m)
#pragma unroll
                for (int n = 0; n < 2; ++n) acc[a][b][m][n] = (f32x4){0.f, 0.f, 0.f, 0.f};
    bf16x8 At[4][2], B0[2][2], B1[2][2];
    const char* cA = (const char*)g.A + (size_t)cur.pm * tstep; const char* cB = (const char*)g.Bt + (size_t)cur.pn * tstep;
    S.a_ready(cur);
    if constexpr (SP2) {
        PG8_STAGE(PG8_SB(0, 0), cB, voffB); PG8_STAGE(PG8_SB(0, 1), cB + hstep, voffB); PG8_STAGE(PG8_SA(0, 0), cA, voffA); PG8_STAGE(PG8_SA(0, 1), cA + hstep, voffA);
        if (wr == 1) PG8_BAR;
        PG8_WAIT_V(2); PG8_BAR;
        PG8_STAGE(PG8_SB(1, 0), cB + kstep, voffB); PG8_STAGE(PG8_SA(1, 0), cA + kstep, voffA); PG8_STAGE(PG8_SB(1, 1), cB + hstep + kstep, voffB);
        PG8_WAIT_V(6); PG8_BAR;
    } else {
        PG8_STAGE(PG8_SB(0, 0), cB, voffB); PG8_STAGE(PG8_SA(0, 0), cA, voffA); PG8_STAGE(PG8_SB(0, 1), cB + hstep, voffB); PG8_STAGE(PG8_SA(0, 1), cA + hstep, voffA);
        if (wr == 1) PG8_BAR;
        PG8_WAIT_V(4); PG8_BAR;
        PG8_STAGE(PG8_SB(1, 0), cB + kstep, voffB); PG8_STAGE(PG8_SA(1, 0), cA + kstep, voffA); PG8_STAGE(PG8_SB(1, 1), cB + hstep + kstep, voffB);
        PG8_WAIT_V(6); PG8_BAR;
    }
    for (;;) {
        const bool has_next = S.next(ui + 1, nxt);
        const char* nA = has_next ? (const char*)g.A + (size_t)nxt.pm * tstep : cA; const char* nB = has_next ? (const char*)g.Bt + (size_t)nxt.pn * tstep : cB;
        for (int t = 0; t < nt; t += 2) {
            const bool last = (t == nt - 2);
            const char* a1 = cA + (size_t)(t + 1) * kstep;
            const char* a2 = last ? nA : cA + (size_t)(t + 2) * kstep; const char* b2 = last ? nB : cB + (size_t)(t + 2) * kstep;
            const char* a3 = a2 + kstep; const char* b3 = b2 + kstep;
            if (last && has_next) S.a_ready(nxt);
            if constexpr (SP2) {
            PG8_LDB(B0, 0, 0); PG8_LDB(B1, 0, 1); PG8_SCHED; PG8_LDA(At, 0, 0); PG8_STAGE(PG8_SA(1, 1), a1 + hstep, voffA);
            PG8_WAIT_V(8); PG8_WAIT_L(0); PG8_BAR; PG8_MMA(0, 0, At, B0); PG8_MMA(0, 1, At, B1); PG8_BAR; PG8_SCHED;
            PG8_LDA(At, 0, 1); PG8_STAGE(PG8_SB(0, 0), b2, voffB); PG8_STAGE(PG8_SB(0, 1), b2 + hstep, voffB); PG8_STAGE(PG8_SA(0, 0), a2, voffA);
            PG8_WAIT_V(8); PG8_WAIT_L(0); PG8_BAR; PG8_MMA(1, 0, At, B0); PG8_MMA(1, 1, At, B1); PG8_BAR; PG8_SCHED;
            PG8_LDB(B0, 1, 0); PG8_LDB(B1, 1, 1); PG8_SCHED; PG8_LDA(At, 1, 0); PG8_STAGE(PG8_SA(0, 1), a2 + hstep, voffA);
            PG8_WAIT_V(8); PG8_WAIT_L(0); PG8_BAR; PG8_MMA(0, 0, At, B0); PG8_MMA(0, 1, At, B1); PG8_BAR; PG8_SCHED;
            PG8_LDA(At, 1, 1); PG8_STAGE(PG8_SB(1, 0), b3, voffB); PG8_STAGE(PG8_SB(1, 1), b3 + hstep, voffB); PG8_STAGE(PG8_SA(1, 0), a3, voffA);
            PG8_WAIT_V(8); PG8_WAIT_L(0); PG8_BAR; PG8_MMA(1, 0, At, B0); PG8_MMA(1, 1, At, B1); PG8_BAR; PG8_SCHED;
            } else {
            PG8_LDB(B0, 0, 0); PG8_SCHED; PG8_LDA(At, 0, 0); PG8_STAGE(PG8_SA(1, 1), a1 + hstep, voffA);
            PG8_WAIT_L(8); PG8_BAR; PG8_WAIT_L(0); PG8_MMA(0, 0, At, B0); PG8_BAR; PG8_SCHED;
            PG8_LDB(B1, 0, 1); PG8_STAGE(PG8_SB(0, 0), b2, voffB);
            PG8_BAR; PG8_WAIT_L(0); PG8_MMA(0, 1, At, B1); PG8_BAR;
            PG8_LDA(At, 0, 1); PG8_STAGE(PG8_SA(0, 0), a2, voffA);
            PG8_BAR; PG8_WAIT_L(0); PG8_MMA(1, 0, At, B0); PG8_BAR; PG8_SCHED;
            PG8_STAGE(PG8_SB(0, 1), b2 + hstep, voffB);
            PG8_WAIT_V(6); PG8_BAR; PG8_MMA(1, 1, At, B1); PG8_BAR;
            PG8_LDB(B0, 1, 0); PG8_SCHED; PG8_LDA(At, 1, 0); PG8_STAGE(PG8_SA(0, 1), a2 + hstep, voffA);
            PG8_WAIT_L(8); PG8_BAR; PG8_WAIT_L(0); PG8_MMA(0, 0, At, B0); PG8_BAR; PG8_SCHED;
            PG8_LDB(B1, 1, 1); PG8_STAGE(PG8_SB(1, 0), b3, voffB);
            PG8_BAR; PG8_WAIT_L(0); PG8_MMA(0, 1, At, B1); PG8_BAR;
            PG8_LDA(At, 1, 1); PG8_STAGE(PG8_SA(1, 0), a3, voffA);
            PG8_BAR; PG8_WAIT_L(0); PG8_MMA(1, 0, At, B0); PG8_BAR; PG8_SCHED;
            PG8_STAGE(PG8_SB(1, 1), b3 + hstep, voffB);
            PG8_WAIT_V(6); PG8_BAR; PG8_MMA(1, 1, At, B1); PG8_BAR;
            }
        }
        if constexpr (ALIGN_EPI) { if (wr == 0) PG8_BAR; }
        if constexpr (!Epi::AFTER_DRAIN) { E(acc, cur, wr, wc, fr, fq); S.done(cur); }
        if (!has_next) break;
#pragma unroll
        for (int a = 0; a < 2; ++a)
#pragma unroll
            for (int b = 0; b < 2; ++b)
#pragma unroll
                for (int m = 0; m < 4; ++m)
#pragma unroll
                    for (int n = 0; n < 2; ++n) acc[a][b][m][n] = (f32x4){0.f, 0.f, 0.f, 0.f};
        cur = nxt; cA = nA; cB = nB; ++ui;
        if constexpr (ALIGN_EPI) { if (wr == 1) PG8_BAR; }
    }
    PG8_WAIT_V(0);
    if constexpr (!ALIGN_EPI) { if (wr == 0) PG8_BAR; }
    PG8_BAR;
    if constexpr (Epi::AFTER_DRAIN) { E.fused(acc, cur, wr, wc, fr, fq, lds, wid, lane); S.done(cur); }
#undef PG8_SA
#undef PG8_SB
#undef PG8_STAGE
#undef PG8_LDA
#undef PG8_LDB
#undef PG8_MMA
#undef PG8_WAIT_V
#undef PG8_WAIT_L
#undef PG8_BAR
#undef PG8_SCHED
}
}

constexpr int NB = 8, T = 2048, D = 1024, M = NB * T;
constexpr int N_EIN = 2816;
constexpr int E_Q = 0, E_K = 256, E_V = 512, E_G = 1024, E_GK = 1536, E_XB = 1792, E_GATE = 2304;
constexpr int FF = 2816, N_F13 = 2 * FF;
constexpr int N_OIN = 4608;
constexpr int O_Z = 0, O_XS = 1024, O_B = 2048, O_C = 2304, O_R = 2560, O_DT = 4352;
constexpr int K_OOUT = 1536, NE = 8, FE = 3584, N_E13 = 2 * FE  ;
constexpr int MOE_MAXP = 136, MOE_CP = 32;
constexpr float LN_EPS = 1e-5f, ALPHA = 1.4142135623730951f;

constexpr size_t MiB = 1u << 20;
constexpr size_t WS_CTL = 0, CTL_ZERO_BYTES = 1 * MiB;
constexpr size_t WS_WEIN = 1 * MiB;
constexpr size_t WS_WEOUT = WS_WEIN + (size_t)N_EIN * D * 2;
constexpr size_t WS_WF13 = WS_WEOUT + (size_t)D * D * 2;
constexpr size_t WS_WF2 = WS_WF13 + (size_t)N_F13 * D * 2;
constexpr size_t WS_WOIN = WS_WF2 + (size_t)D * FF * 2;
constexpr size_t WS_WOOUT = WS_WOIN + (size_t)N_OIN * D * 2;
constexpr size_t WS_ROUTE = 37 * MiB;
constexpr size_t WS_EXP13 = 38 * MiB;
constexpr size_t WS_EXP2 = 150 * MiB;
constexpr size_t WS_DEC = 38 * MiB, WS_AA = 70 * MiB, WS_GG = 102 * MiB, WS_SSDY = 134 * MiB;
constexpr size_t WS_XBF = 206 * MiB;
constexpr size_t WS_P = 238 * MiB;
constexpr size_t WS_MIX0 = 326 * MiB;
constexpr size_t WS_Y = 358 * MiB;
constexpr size_t WS_MIX1 = 422 * MiB;
constexpr size_t WS_XY = 238 * MiB;
constexpr size_t WS_HE = 306 * MiB, HE_BYTES = (size_t)MOE_CP * 256 * FE * 2;
constexpr size_t WS_END = 470 * MiB;
static_assert(WS_WOOUT + (size_t)D * K_OOUT * 2 <= WS_ROUTE && WS_P + (size_t)M * N_OIN * 2 <= WS_MIX1 && WS_HE + 2 * HE_BYTES <= WS_MIX1 && WS_MIX1 + (size_t)M * K_OOUT * 2 <= WS_END, "d_ws map");
static_assert(WS_XY + (size_t)MOE_MAXP * 256 * D * 2 <= WS_HE && WS_EXP2 + (size_t)NE * D * FE * 2 <= WS_XBF && WS_SSDY + (size_t)M * D * 4 <= WS_XBF, "d_ws map 2");
constexpr size_t RT_E = 0, RT_P = 128 * 1024, RT_W = 256 * 1024, RT_DST = 384 * 1024;
constexpr int CW_TMO = 0, CW_CODE = 1, CW_BAR = 4096, CW_CNT = 16384;

constexpr int NWAVES = 8;
constexpr int RING_OFF = 0, RING_BYTES = 131072;
constexpr int LDSCTL_OFF = RING_BYTES, MISC_OFF = LDSCTL_OFF + 320, PE_OFF = MISC_OFF + 128;
constexpr int LDS_BYTES = 147456;
static_assert(PE_OFF + 4 * 192 <= LDS_BYTES, "LDS map");

#define GAS __attribute__((address_space(1)))
#define LAS __attribute__((address_space(3)))
typedef unsigned short bf16;
typedef unsigned v4u __attribute__((ext_vector_type(4)));
typedef unsigned v2u __attribute__((ext_vector_type(2)));
typedef float f32x4 __attribute__((ext_vector_type(4)));
typedef GAS unsigned gu32;
#define RLX_AGENT __ATOMIC_RELAXED, __HIP_MEMORY_SCOPE_AGENT
#define LDS_WAIT() asm volatile("s_waitcnt lgkmcnt(0)" ::: "memory")
#define VM_WAIT() asm volatile("s_waitcnt vmcnt(0)" ::: "memory")
__device__ __forceinline__ unsigned f2bf(float f) { unsigned u = __builtin_bit_cast(unsigned, f); return (u + 0x7fffu + ((u >> 16) & 1u)) >> 16; }
__device__ __forceinline__ unsigned pk2(float lo, float hi) { return f2bf(lo) | (f2bf(hi) << 16); }

#define XB_TMO      128
#define XB_XCNT(j)  (256  + 64 * (j))
#define XB_XSUB(j)  (1280 + 64 * (j))
#define XB_XGEN(j)  (2304 + 64 * (j))
#define XB_TOP      3328
#define XB_TOPGEN   3392
#define XCD_BAR_WORDS 3456
#define XB_SPIN_CAP (1u << 18)

__device__ __forceinline__ unsigned xb_ld(unsigned* p)              { return __hip_atomic_load(p, __ATOMIC_RELAXED, __HIP_MEMORY_SCOPE_AGENT); }
__device__ __forceinline__ unsigned xb_add(unsigned* p, unsigned v) { return __hip_atomic_fetch_add(p, v, __ATOMIC_RELAXED, __HIP_MEMORY_SCOPE_AGENT); }
__device__ __forceinline__ unsigned xb_xcc_id() { return (unsigned)__builtin_amdgcn_s_getreg((3 << 11) | 20) & 0xFu; }
#define XB_SPIN(cond, bar) do { unsigned _sp = 0; while (cond) { __builtin_amdgcn_s_sleep(1); \
    if ((++_sp & 255u) == 0u) { if (xb_ld(&(bar)[XB_TMO])) break; if (_sp > XB_SPIN_CAP) { atomicAdd(&(bar)[XB_TMO], 1u); break; } } } } while (0)

struct XcdBarrier {
    unsigned* bar; unsigned x;
    volatile LAS unsigned* st;
};

__device__ __forceinline__ XcdBarrier xcd_barrier_post(unsigned* bar, volatile LAS unsigned* st) {
    XcdBarrier b; b.bar = bar; b.x = xb_xcc_id(); b.st = st;
    if (threadIdx.x == 0) (void)xb_add(&bar[XB_XCNT(b.x)], 1u);
    return b;
}
__device__ __forceinline__ void xcd_barrier_complete(unsigned* bar, unsigned x, unsigned& nloc, unsigned& nx) {
    const unsigned G = gridDim.x * gridDim.y * gridDim.z;
    unsigned sum, cnt, mine, sp = 0u;
    for (;;) {
        sum = 0u; cnt = 0u; mine = 0u;
#pragma unroll
        for (unsigned j = 0; j < 16; ++j) { const unsigned c = xb_ld(&bar[XB_XCNT(j)]); sum += c; cnt += (c > 0u) ? 1u : 0u; mine = (j == x) ? c : mine; }
        if (sum == G) break;
        __builtin_amdgcn_s_sleep(1);
        if ((++sp & 255u) == 0u) { if (xb_ld(&bar[XB_TMO])) break; if (sp > XB_SPIN_CAP) { atomicAdd(&bar[XB_TMO], 1u); break; } }
    }
    nloc = mine > 0u ? mine : 1u; nx = cnt > 0u ? cnt : 1u;
}

__device__ __forceinline__ void xcd_barrier(const XcdBarrier& b) {
    asm volatile("s_waitcnt vmcnt(0)" ::: "memory");
    __syncthreads();
    if (threadIdx.x == 0) {
        unsigned* bar = b.bar;
        __builtin_amdgcn_s_waitcnt(0);
        unsigned nloc = b.st[0], nx = b.st[1];
        if (nloc == 0u) { xcd_barrier_complete(bar, b.x, nloc, nx); b.st[0] = nloc; b.st[1] = nx; }
        const unsigned old = xb_add(&bar[XB_XSUB(b.x)], 1u);
        const unsigned gen = old / nloc;
        if (old + 1u == (gen + 1u) * nloc) {
            __builtin_amdgcn_fence(__ATOMIC_RELEASE, "agent");
            asm volatile("s_waitcnt vmcnt(0)" ::: "memory");
            const unsigned og = xb_add(&bar[XB_TOP], 1u);
            const unsigned tg = og / nx;
            if (og + 1u == (tg + 1u) * nx) xb_add(&bar[XB_TOPGEN], 1u);
            else XB_SPIN(xb_ld(&bar[XB_TOPGEN]) == tg, bar);
            __builtin_amdgcn_fence(__ATOMIC_ACQUIRE, "agent");
            xb_add(&bar[XB_XGEN(b.x)], 1u);
            asm volatile("s_waitcnt vmcnt(0)" ::: "memory");
        } else {
            XB_SPIN(xb_ld(&bar[XB_XGEN(b.x)]) == gen, bar);
            __builtin_amdgcn_fence(__ATOMIC_ACQUIRE, "agent");
            asm volatile("s_waitcnt vmcnt(0)" ::: "memory");
        }
    }
    __syncthreads();
}

__device__ __forceinline__ float bf2f(bf16 b) { return __uint_as_float(((unsigned)b) << 16); }
__device__ __forceinline__ float wave_sum(float v) {
#pragma unroll
    for (int o = 1; o < 64; o <<= 1) v += __shfl_xor(v, o);
    return v;
}
__device__ __forceinline__ float sigmoid_f(float x) { return 1.0f / (1.0f + expf(-x)); }
__device__ __forceinline__ float silu_x(float x) { return x / (1.0f + expf(-x)); }
__device__ __forceinline__ float softplus_f(float x) { return fmaxf(x, 0.0f) + log1pf(expf(-fabsf(x))); }
__device__ __forceinline__ float logsigmoid_f(float x) { return fminf(x, 0.0f) - log1pf(expf(-fabsf(x))); }
__device__ __forceinline__ float gelu_tanh_f(float x) { const float u = 0.7978845608028654f * (x + 0.044715f * x * x * x); return 0.5f * x * (1.0f + tanhf(u)); }

__device__ __forceinline__ void tr_item(const float* W, size_t ldw, int scol0, int nvalid, bf16* WT, int K, int drow0, int k0, LAS float* scr, int lane) {
    const int j = lane & 31;
#pragma unroll 8
    for (int i = 0; i < 32; ++i) { const int kk = 2 * i + (lane >> 5); scr[kk * 33 + j] = (j < nvalid) ? W[(size_t)(k0 + kk) * ldw + scol0 + j] : 0.0f; }
    LDS_WAIT(); asm volatile("" ::: "memory");
    const int c = lane & 7;
#pragma unroll
    for (int jj = 0; jj < 4; ++jj) { const int n = (lane >> 3) + 8 * jj; const LAS float* s = scr + (8 * c) * 33 + n;
        v4u o; o.x = pk2(s[0 * 33], s[1 * 33]); o.y = pk2(s[2 * 33], s[3 * 33]); o.z = pk2(s[4 * 33], s[5 * 33]); o.w = pk2(s[6 * 33], s[7 * 33]);
        *(GAS v4u*)(WT + (size_t)(drow0 + n) * K + k0 + 8 * c) = o; }
    LDS_WAIT(); asm volatile("" ::: "memory");
}
constexpr int IT_EIN = (N_EIN / 32) * (D / 64), IT_EOUT = (D / 32) * (D / 64), IT_F13 = (N_F13 / 32) * (D / 64), IT_F2 = (D / 32) * (FF / 64), IT_OIN = (N_OIN / 32) * (D / 64), IT_OOUT = (D / 32) * (K_OOUT / 64);
constexpr int IT_SMALL = IT_EIN + IT_EOUT + IT_F13 + IT_F2 + IT_OIN + IT_OOUT;
constexpr int IT_E13 = (NE * N_E13 / 32) * (D / 64), IT_E2 = (NE * D / 32) * (FE / 64), IT_EXP = IT_E13 + IT_E2;

__device__ __forceinline__ void cvt_small_item(const float* const* in, unsigned char* ws, int it, LAS float* scr, int lane) {
    int r = it;
    if (r < IT_EIN) { const int db = r / (D / 64), kb = r % (D / 64), r0 = 32 * db;
        if (r0 >= E_GK && r0 < E_XB) return;
        const int sc = r0 < E_GK ? r0 : r0 - 240;
        tr_item(in[1], 2576, sc, 32, (bf16*)(ws + WS_WEIN), D, r0, 64 * kb, scr, lane); return; } r -= IT_EIN;
    if (r < IT_EOUT) { const int db = r / (D / 64), kb = r % (D / 64); tr_item(in[12], D, 32 * db, 32, (bf16*)(ws + WS_WEOUT), D, 32 * db, 64 * kb, scr, lane); return; } r -= IT_EOUT;
    if (r < IT_F13) { const int db = r / (D / 64), kb = r % (D / 64), r0 = 32 * db, tile = r0 >> 8, within = r0 & 255;
        tr_item(within < 128 ? in[15] : in[16], FF, tile * 128 + (within & 127), 32, (bf16*)(ws + WS_WF13), D, r0, 64 * kb, scr, lane); return; } r -= IT_F13;
    if (r < IT_F2) { const int db = r / (FF / 64), kb = r % (FF / 64); tr_item(in[17], D, 32 * db, 32, (bf16*)(ws + WS_WF2), FF, 32 * db, 64 * kb, scr, lane); return; } r -= IT_F2;
    if (r < IT_OIN) { const int db = r / (D / 64), kb = r % (D / 64), r0 = 32 * db;
        int sc, nv; if (r0 < O_R) { sc = r0; nv = 32; } else if (r0 < O_DT) { sc = r0 + 16; nv = 32; } else if (r0 == O_DT) { sc = 2560; nv = 16; } else { sc = 0; nv = 0; }
        tr_item(in[20], 4368, sc, nv, (bf16*)(ws + WS_WOIN), D, r0, 64 * kb, scr, lane); return; } r -= IT_OIN;
    { const int db = r / (K_OOUT / 64), kb = r % (K_OOUT / 64); tr_item(in[38], D, 32 * db, 32, (bf16*)(ws + WS_WOOUT), K_OOUT, 32 * db, 64 * kb, scr, lane); }
}
__device__ __forceinline__ void cvt_exp_item(const float* const* in, unsigned char* ws, int it, LAS float* scr, int lane) {
    int r = it;
    if (r < IT_E13) { const int db = r / (D / 64), kb = r % (D / 64), r0 = 32 * db, e = r0 / N_E13, rr = r0 - e * N_E13, tile = rr >> 8, within = rr & 255;
        const float* W = (within < 128 ? in[42] : in[43]) + (size_t)e * D * FE;
        tr_item(W, FE, tile * 128 + (within & 127), 32, (bf16*)(ws + WS_EXP13), D, r0, 64 * kb, scr, lane); return; } r -= IT_E13;
    { const int db = r / (FE / 64), kb = r % (FE / 64), r0 = 32 * db, e = r0 / D;
        tr_item(in[44] + (size_t)e * FE * D, D, r0 - e * D, 32, (bf16*)(ws + WS_EXP2), FE, r0, 64 * kb, scr, lane); }
}

template <int MODE>
__device__ __forceinline__ void ln_rows(const float* xin, const float* y, const float* gam, const float* bet, float* outf, bf16* outb,
                                        const float* router, unsigned char* ws, gu32* ctl, int gw, int NGW, int lane) {
    for (int m = gw; m < M; m += NGW) {
        const GAS f32x4* xr = (const GAS f32x4*)(xin + (size_t)m * D) + lane;
        f32x4 v[4];
        if (MODE == 2) {
            const int* rdst = (const int*)(ws + WS_ROUTE + RT_DST) + 2 * m; const float* rw = (const float*)(ws + WS_ROUTE + RT_W) + 2 * m;
            const int d0 = rdst[0], d1 = rdst[1]; const float w0 = rw[0], w1 = rw[1];
            const GAS v2u* y0 = (const GAS v2u*)((const bf16*)(ws + WS_XY) + (size_t)d0 * D) + lane; const GAS v2u* y1 = (const GAS v2u*)((const bf16*)(ws + WS_XY) + (size_t)d1 * D) + lane;
#pragma unroll
            for (int j = 0; j < 4; ++j) { const v2u a = y0[64 * j], b = y1[64 * j]; const f32x4 xv = xr[64 * j];
                v[j].x = ALPHA * xv.x + w0 * __uint_as_float(a.x << 16) + w1 * __uint_as_float(b.x << 16);
                v[j].y = ALPHA * xv.y + w0 * __uint_as_float(a.x & 0xffff0000u) + w1 * __uint_as_float(b.x & 0xffff0000u);
                v[j].z = ALPHA * xv.z + w0 * __uint_as_float(a.y << 16) + w1 * __uint_as_float(b.y << 16);
                v[j].w = ALPHA * xv.w + w0 * __uint_as_float(a.y & 0xffff0000u) + w1 * __uint_as_float(b.y & 0xffff0000u); }
        } else {
            const GAS f32x4* yr = (const GAS f32x4*)(y + (size_t)m * D) + lane;
#pragma unroll
            for (int j = 0; j < 4; ++j) { const f32x4 xv = xr[64 * j], yv = yr[64 * j]; v[j] = xv * ALPHA + yv; }
        }
        float s = 0.f;
#pragma unroll
        for (int j = 0; j < 4; ++j) s += (v[j].x + v[j].y) + (v[j].z + v[j].w);
        const float mean = wave_sum(s) * (1.f / D); float s2 = 0.f;
#pragma unroll
        for (int j = 0; j < 4; ++j) { v[j] = v[j] - mean; s2 += (v[j].x * v[j].x + v[j].y * v[j].y) + (v[j].z * v[j].z + v[j].w * v[j].w); }
        const float rstd = 1.f / sqrtf(wave_sum(s2) * (1.f / D) + LN_EPS);
        GAS f32x4* of = (GAS f32x4*)(outf + (size_t)m * D) + lane;
#pragma unroll
        for (int j = 0; j < 4; ++j) { const f32x4 gv = ((const GAS f32x4*)gam)[lane + 64 * j], bv = ((const GAS f32x4*)bet)[lane + 64 * j]; v[j] = v[j] * rstd * gv + bv; of[64 * j] = v[j]; }
        if (MODE != 2) { GAS v2u* ob = (GAS v2u*)(outb + (size_t)m * D) + lane;
#pragma unroll
            for (int j = 0; j < 4; ++j) { v2u o; o.x = pk2(v[j].x, v[j].y); o.y = pk2(v[j].z, v[j].w); ob[64 * j] = o; } }
        if (MODE == 1) {
            float lg[8];
#pragma unroll
            for (int e = 0; e < 8; ++e) lg[e] = 0.f;
#pragma unroll
            for (int j = 0; j < 4; ++j) {
#pragma unroll
                for (int i = 0; i < 4; ++i) { const int c = 4 * lane + 256 * j + i; const f32x4 r0 = ((const GAS f32x4*)router)[2 * c], r1 = ((const GAS f32x4*)router)[2 * c + 1]; const float xv = v[j][i];
                    lg[0] += xv * r0.x; lg[1] += xv * r0.y; lg[2] += xv * r0.z; lg[3] += xv * r0.w; lg[4] += xv * r1.x; lg[5] += xv * r1.y; lg[6] += xv * r1.z; lg[7] += xv * r1.w; } }
#pragma unroll
            for (int e = 0; e < 8; ++e) lg[e] = wave_sum(lg[e]);
            int i0 = 0; float v0 = lg[0];
#pragma unroll
            for (int e = 1; e < 8; ++e) if (lg[e] > v0) { v0 = lg[e]; i0 = e; }
            int i1 = -1; float v1 = -INFINITY;
#pragma unroll
            for (int e = 0; e < 8; ++e) if (e != i0 && lg[e] > v1) { v1 = lg[e]; i1 = e; }
            const float w0 = 1.0f / (1.0f + expf(v1 - v0)), w1 = 1.0f - w0;
            if (lane == 0) {
                const unsigned p0 = __hip_atomic_fetch_add(ctl + CW_CNT + 64 * i0, 1u, RLX_AGENT), p1 = __hip_atomic_fetch_add(ctl + CW_CNT + 64 * i1, 1u, RLX_AGENT);
                int* re = (int*)(ws + WS_ROUTE + RT_E) + 2 * m; int* rp = (int*)(ws + WS_ROUTE + RT_P) + 2 * m; float* rw = (float*)(ws + WS_ROUTE + RT_W) + 2 * m;
                re[0] = i0; re[1] = i1; rp[0] = (int)p0; rp[1] = (int)p1; rw[0] = w0; rw[1] = w1; }
        }
    }
}

__device__ __forceinline__ void gla_item(const float* const* in, unsigned char* ws, LAS float* L, int item, int tid) {
    const int b = item >> 2, h = item & 3, lane = tid & 63, wave = tid >> 6;
    const bf16* P = (const bf16*)(ws + WS_P); bf16* mix = (bf16*)(ws + WS_MIX0);
    const float* gk_b = in[3]; const float* gnorm = in[4];
    constexpr int TB = 32;
    LAS float* qs = L; LAS float* ks = qs + TB * 64; LAS float* eg = ks + TB * 64; LAS float* vs = eg + TB * 64; LAS float* gs = vs + TB * 128; LAS float* ob = gs + TB * 128;
    const int v = tid >> 2, kq = tid & 3;
    float S[16];
#pragma unroll
    for (int j = 0; j < 16; ++j) S[j] = 0.f;
    for (int t0 = 0; t0 < T; t0 += TB) {
        for (int idx = tid; idx < TB * 64; idx += 512) { const int t = idx >> 6, d = idx & 63; const bf16* pr = P + (size_t)(b * T + t0 + t) * N_EIN;
            qs[idx] = bf2f(pr[E_Q + h * 64 + d]) * 0.125f; ks[idx] = bf2f(pr[E_K + h * 64 + d]);
            const float pre = bf2f(pr[E_GK + h * 64 + d]) + gk_b[h * 64 + d]; eg[idx] = expf(logsigmoid_f(pre) * (1.0f / 16.0f)); }
        for (int idx = tid; idx < TB * 128; idx += 512) { const int t = idx >> 7, c = idx & 127; const bf16* pr = P + (size_t)(b * T + t0 + t) * N_EIN;
            vs[idx] = bf2f(pr[E_V + h * 128 + c]); gs[idx] = bf2f(pr[E_G + h * 128 + c]); }
        __syncthreads();
#pragma unroll 2
        for (int t = 0; t < TB; ++t) {
            const float vv = vs[t * 128 + v]; float acc = 0.f;
#pragma unroll
            for (int j = 0; j < 16; ++j) { const int d = 16 * kq + j; S[j] = S[j] * eg[t * 64 + d] + ks[t * 64 + d] * vv; acc += qs[t * 64 + d] * S[j]; }
            acc += __shfl_xor(acc, 1); acc += __shfl_xor(acc, 2);
            if (kq == 0) ob[t * 128 + v] = acc;
        }
        __syncthreads();
        for (int i = 0; i < 4; ++i) { const int t = wave * 4 + i; const float o0 = ob[t * 128 + lane], o1 = ob[t * 128 + 64 + lane];
            const float rs = 1.0f / sqrtf(wave_sum(o0 * o0 + o1 * o1) * (1.0f / 128.0f) + 1e-5f);
            bf16* mr = mix + (size_t)(b * T + t0 + t) * D + h * 128;
            mr[lane] = (bf16)f2bf(o0 * rs * gnorm[lane] * silu_x(gs[t * 128 + lane])); mr[64 + lane] = (bf16)f2bf(o1 * rs * gnorm[64 + lane] * silu_x(gs[t * 128 + 64 + lane])); }
        __syncthreads();
    }
}
__device__ __forceinline__ void lru_item(const float* const* in, unsigned char* ws, LAS float* L, int item, int tid) {
    const int b = item >> 3, n = item & 7;
    const bf16* P = (const bf16*)(ws + WS_P); bf16* mix = (bf16*)(ws + WS_MIX0);
    const float* conv_w = in[5]; const float* conv_b = in[6]; const float* wa = in[7] + n * 4096; const float* ba = in[8]; const float* wx = in[9] + n * 4096; const float* bx = in[10]; const float* lam = in[11];
    LAS float* xbw = L; LAS float* xc = xbw + 67 * 64; LAS float* was = xc + 4096; LAS float* wxs = was + 4096; LAS float* aa = wxs + 4096; LAS float* uu = aa + 4096;
    for (int idx = tid; idx < 4096; idx += 512) { was[idx] = wa[idx]; wxs[idx] = wx[idx]; }
    const int c = tid & 63, tq = tid >> 6, ch = n * 64 + c;
    const float cw0 = conv_w[ch], cw1 = conv_w[512 + ch], cw2 = conv_w[1024 + ch], cw3 = conv_w[1536 + ch], cb = conv_b[ch];
    const float bac = ba[ch], bxc = bx[ch], spl = softplus_f(-lam[ch]);
    float hcarry = 0.f;
    for (int t0 = 0; t0 < T; t0 += 64) {
        for (int idx = tid; idx < 67 * 64; idx += 512) { const int r = idx >> 6, cc = idx & 63, tt = t0 - 3 + r;
            xbw[idx] = tt >= 0 ? bf2f(P[(size_t)(b * T + tt) * N_EIN + E_XB + n * 64 + cc]) : 0.f; }
        __syncthreads();
        for (int i = 0; i < 8; ++i) { const int t = tq * 8 + i; xc[t * 64 + c] = cb + cw0 * xbw[t * 64 + c] + cw1 * xbw[(t + 1) * 64 + c] + cw2 * xbw[(t + 2) * 64 + c] + cw3 * xbw[(t + 3) * 64 + c]; }
        __syncthreads();
#pragma unroll 1
        for (int i = 0; i < 8; ++i) { const int t = tq * 8 + i; float sr = bac, si = bxc;
#pragma unroll 8
            for (int k = 0; k < 64; ++k) { const float xv = xc[t * 64 + k]; sr += xv * was[k * 64 + c]; si += xv * wxs[k * 64 + c]; }
            const float r = sigmoid_f(sr), ig = sigmoid_f(si), log_a = -8.0f * r * spl;
            aa[t * 64 + c] = expf(log_a); uu[t * 64 + c] = sqrtf(-expm1f(2.0f * log_a)) * (ig * xc[t * 64 + c]); }
        __syncthreads();
        if (tid < 64) { float hh = hcarry;
#pragma unroll 4
            for (int t = 0; t < 64; ++t) { hh = aa[t * 64 + c] * hh + uu[t * 64 + c]; uu[t * 64 + c] = hh; } hcarry = hh; }
        __syncthreads();
        for (int i = 0; i < 8; ++i) { const int t = tq * 8 + i; const size_t m = (size_t)(b * T + t0 + t);
            const float gt = bf2f(P[m * N_EIN + E_GATE + ch]); mix[m * D + 512 + ch] = (bf16)f2bf(uu[t * 64 + c] * gelu_tanh_f(gt)); }
        __syncthreads();
    }
}

__device__ __forceinline__ void ssd_item(const float* const* in, unsigned char* ws, LAS float* L, int item, int tid) {
    const int b = item >> 4, h = item & 15, g = h >> 3;
    const bf16* P = (const bf16*)(ws + WS_P); float* ssdy = (float*)(ws + WS_SSDY);
    const float* conv_w = in[21]; const float* conv_b = in[22];
    const float dtb = in[23][h], a_h = -expf(in[24][h]), dsk = in[25][h];
    constexpr int TB = 32;
    LAS float* raw = L; LAS float* xs = raw + (TB + 3) * 320; LAS float* Bs = xs + TB * 64; LAS float* Cs = Bs + TB * 128; LAS float* dts = Cs + TB * 128; LAS float* das = dts + TB;
    const int p = tid >> 3, sq = tid & 7;
    float st[16];
#pragma unroll
    for (int j = 0; j < 16; ++j) st[j] = 0.f;
    for (int t0 = 0; t0 < T; t0 += TB) {
        for (int idx = tid; idx < (TB + 3) * 320; idx += 512) { const int r = idx / 320, j = idx - r * 320, tt = t0 - 3 + r;
            const int col = j < 64 ? O_XS + h * 64 + j : (j < 192 ? O_B + g * 128 + (j - 64) : O_C + g * 128 + (j - 192));
            raw[idx] = tt >= 0 ? bf2f(P[(size_t)(b * T + tt) * N_OIN + col]) : 0.f; }
        if (tid < TB) { const float dt = softplus_f(bf2f(P[(size_t)(b * T + t0 + tid) * N_OIN + O_DT + h]) + dtb); dts[tid] = dt; das[tid] = expf(dt * a_h); }
        __syncthreads();
        for (int idx = tid; idx < TB * 320; idx += 512) { const int t = idx / 320, j = idx - t * 320;
            const int ch = j < 64 ? h * 64 + j : (j < 192 ? 1024 + g * 128 + (j - 64) : 1280 + g * 128 + (j - 192));
            const float cv = conv_b[ch] + conv_w[ch] * raw[t * 320 + j] + conv_w[1536 + ch] * raw[(t + 1) * 320 + j] + conv_w[3072 + ch] * raw[(t + 2) * 320 + j] + conv_w[4608 + ch] * raw[(t + 3) * 320 + j];
            const float sv = silu_x(cv);
            if (j < 64) xs[t * 64 + j] = sv; else if (j < 192) Bs[t * 128 + (j - 64)] = sv; else Cs[t * 128 + (j - 192)] = sv; }
        __syncthreads();
#pragma unroll 2
        for (int t = 0; t < TB; ++t) {
            const float xv = xs[t * 64 + p], xdt = xv * dts[t], dA = das[t]; float acc = 0.f;
#pragma unroll
            for (int j = 0; j < 16; ++j) { const int s = 16 * sq + j; st[j] = st[j] * dA + xdt * Bs[t * 128 + s]; acc += Cs[t * 128 + s] * st[j]; }
            acc += __shfl_xor(acc, 1); acc += __shfl_xor(acc, 2); acc += __shfl_xor(acc, 4);
            if (sq == 0) ssdy[(size_t)(b * T + t0 + t) * D + h * 64 + p] = acc + dsk * xv;
        }
        __syncthreads();
    }
}
__device__ __forceinline__ void ssd_norm_rows(const float* const* in, unsigned char* ws, int gw, int NGW, int lane) {
    const bf16* P = (const bf16*)(ws + WS_P); const float* ssdy = (const float*)(ws + WS_SSDY); bf16* mix = (bf16*)(ws + WS_MIX1); const float* nw = in[26];
    for (int m = gw; m < M; m += NGW) {
        float yv[16]; float ss = 0.f;
#pragma unroll
        for (int q = 0; q < 4; ++q) { const f32x4 y4 = *(const GAS f32x4*)(ssdy + (size_t)m * D + 16 * lane + 4 * q); const v2u z2 = *(const GAS v2u*)(P + (size_t)m * N_OIN + O_Z + 16 * lane + 4 * q);
            const float z0 = __uint_as_float(z2.x << 16), z1 = __uint_as_float(z2.x & 0xffff0000u), z2f = __uint_as_float(z2.y << 16), z3 = __uint_as_float(z2.y & 0xffff0000u);
            yv[4 * q] = y4.x * silu_x(z0); yv[4 * q + 1] = y4.y * silu_x(z1); yv[4 * q + 2] = y4.z * silu_x(z2f); yv[4 * q + 3] = y4.w * silu_x(z3); }
#pragma unroll
        for (int i = 0; i < 16; ++i) ss += yv[i] * yv[i];
#pragma unroll
        for (int o = 1; o < 32; o <<= 1) ss += __shfl_xor(ss, o);
        const float rs = 1.0f / sqrtf(ss * (1.0f / 512.0f) + 1e-5f);
        v4u o0, o1;
        o0.x = pk2(yv[0] * rs * nw[16 * lane + 0], yv[1] * rs * nw[16 * lane + 1]); o0.y = pk2(yv[2] * rs * nw[16 * lane + 2], yv[3] * rs * nw[16 * lane + 3]);
        o0.z = pk2(yv[4] * rs * nw[16 * lane + 4], yv[5] * rs * nw[16 * lane + 5]); o0.w = pk2(yv[6] * rs * nw[16 * lane + 6], yv[7] * rs * nw[16 * lane + 7]);
        o1.x = pk2(yv[8] * rs * nw[16 * lane + 8], yv[9] * rs * nw[16 * lane + 9]); o1.y = pk2(yv[10] * rs * nw[16 * lane + 10], yv[11] * rs * nw[16 * lane + 11]);
        o1.z = pk2(yv[12] * rs * nw[16 * lane + 12], yv[13] * rs * nw[16 * lane + 13]); o1.w = pk2(yv[14] * rs * nw[16 * lane + 14], yv[15] * rs * nw[16 * lane + 15]);
        GAS v4u* mo = (GAS v4u*)(mix + (size_t)m * K_OOUT + 16 * lane); mo[0] = o0; mo[1] = o1;
    }
}
__device__ __forceinline__ void rwkv_pre_tile(const float* const* in, unsigned char* ws, LAS float* L, int tile, int tid) {
    const bf16* P = (const bf16*)(ws + WS_P); const float* mu = in[27];
    float* DEC = (float*)(ws + WS_DEC); float* AA = (float*)(ws + WS_AA); float* GG = (float*)(ws + WS_GG);
    LAS float* tw = L; LAS float* xa = tw + 32 * 64; LAS float* sg = xa + 32 * 64;
    const int m0 = tile * 32;
    for (int idx = tid; idx < 32 * 256; idx += 512) { const int t = idx >> 8, c = idx & 255, m = m0 + t;
        const float cur = bf2f(P[(size_t)m * N_OIN + O_R + 1536 + c]); const float prev = (m % T) ? bf2f(P[(size_t)(m - 1) * N_OIN + O_R + 1536 + c]) : 0.f;
        const float pm = cur + (prev - cur) * mu[1536 + c];
        if (c < 64) tw[t * 64 + c] = tanhf(pm); else if (c < 128) xa[t * 64 + (c - 64)] = pm; else sg[t * 128 + (c - 128)] = sigmoid_f(pm); }
    __syncthreads();
    const int j = tid; float acc[32];
#pragma unroll
    for (int t = 0; t < 32; ++t) acc[t] = 0.f;
    for (int i = 0; i < 64; i += 4) { const float w0 = in[29][(i) * 512 + j], w1 = in[29][(i + 1) * 512 + j], w2 = in[29][(i + 2) * 512 + j], w3 = in[29][(i + 3) * 512 + j];
#pragma unroll
        for (int t = 0; t < 32; ++t) { const f32x4 x = *(const LAS f32x4*)(tw + t * 64 + i); acc[t] += x.x * w0 + x.y * w1 + x.z * w2 + x.w * w3; } }
    { const float w0j = in[28][j];
#pragma unroll
      for (int t = 0; t < 32; ++t) { const float wl = -softplus_f(-(w0j + acc[t])) - 0.5f; DEC[(size_t)(m0 + t) * 512 + j] = expf(-expf(wl)); } }
#pragma unroll
    for (int t = 0; t < 32; ++t) acc[t] = 0.f;
    for (int i = 0; i < 64; i += 4) { const float w0 = in[31][(i) * 512 + j], w1 = in[31][(i + 1) * 512 + j], w2 = in[31][(i + 2) * 512 + j], w3 = in[31][(i + 3) * 512 + j];
#pragma unroll
        for (int t = 0; t < 32; ++t) { const f32x4 x = *(const LAS f32x4*)(xa + t * 64 + i); acc[t] += x.x * w0 + x.y * w1 + x.z * w2 + x.w * w3; } }
    { const float a0j = in[30][j];
#pragma unroll
      for (int t = 0; t < 32; ++t) AA[(size_t)(m0 + t) * 512 + j] = sigmoid_f(a0j + acc[t]); }
#pragma unroll
    for (int t = 0; t < 32; ++t) acc[t] = 0.f;
    for (int i = 0; i < 128; i += 4) { const float w0 = in[32][(i) * 512 + j], w1 = in[32][(i + 1) * 512 + j], w2 = in[32][(i + 2) * 512 + j], w3 = in[32][(i + 3) * 512 + j];
#pragma unroll
        for (int t = 0; t < 32; ++t) { const f32x4 x = *(const LAS f32x4*)(sg + t * 128 + i); acc[t] += x.x * w0 + x.y * w1 + x.z * w2 + x.w * w3; } }
#pragma unroll
    for (int t = 0; t < 32; ++t) GG[(size_t)(m0 + t) * 512 + j] = acc[t];
    __syncthreads();
}
__device__ __forceinline__ void rwkv_item(const float* const* in, unsigned char* ws, LAS float* L, int item, int tid) {
    const int b = item >> 3, h = item & 7, lane = tid & 63, wave = tid >> 6;
    const bf16* P = (const bf16*)(ws + WS_P); const float* mu = in[27]; bf16* mix = (bf16*)(ws + WS_MIX1);
    const float* DEC = (const float*)(ws + WS_DEC); const float* AA = (const float*)(ws + WS_AA); const float* GG = (const float*)(ws + WS_GG);
    constexpr int TB = 32;
    LAS float* rs = L; LAS float* wsd = rs + TB * 64; LAS float* k2s = wsd + TB * 64; LAS float* vs = k2s + TB * 64; LAS float* avs = vs + TB * 64; LAS float* bvs = avs + TB * 64; LAS float* yb = bvs + TB * 64; LAS float* bsum = yb + TB * 64;
    const int hc = h * 64 + lane;
    const float mu_r = mu[hc], mu_k = mu[512 + hc], mu_v = mu[1024 + hc], kk_c = in[33][hc], ka_c = in[34][hc], rk_c = in[35][hc], lng = in[36][hc], lnb = in[37][hc];
    const int i = tid >> 3, kq = tid & 7;
    float S[8];
#pragma unroll
    for (int j = 0; j < 8; ++j) S[j] = 0.f;
    for (int t0 = 0; t0 < T; t0 += TB) {
        for (int q = 0; q < 4; ++q) { const int t = wave * 4 + q; const size_t m = (size_t)(b * T + t0 + t); const bf16* pr = P + m * N_OIN + O_R + hc;
            const bool has_prev = (t0 + t) > 0; const bf16* pp = pr - N_OIN;
            const float rc = bf2f(pr[0]), kc = bf2f(pr[512]), vc = bf2f(pr[1024]);
            const float rp = has_prev ? bf2f(pp[0]) : 0.f, kp = has_prev ? bf2f(pp[512]) : 0.f, vp = has_prev ? bf2f(pp[1024]) : 0.f;
            const float r_ = rc + (rp - rc) * mu_r, k_ = kc + (kp - kc) * mu_k, v_ = vc + (vp - vc) * mu_v;
            const float a_ = AA[m * 512 + hc], d_ = DEC[m * 512 + hc];
            const float kkr = k_ * kk_c; const float nrm = sqrtf(wave_sum(kkr * kkr)); const float kk = kkr / fmaxf(nrm, 1e-12f);
            const float k2 = k_ * (1.0f + (a_ - 1.0f) * ka_c);
            rs[t * 64 + lane] = r_; wsd[t * 64 + lane] = d_; k2s[t * 64 + lane] = k2; vs[t * 64 + lane] = v_; avs[t * 64 + lane] = -kk; bvs[t * 64 + lane] = kk * a_;
            const float bs = wave_sum(r_ * k2 * rk_c); if (lane == 0) bsum[t] = bs; }
        __syncthreads();
#pragma unroll 2
        for (int t = 0; t < TB; ++t) {
            float sa = 0.f;
#pragma unroll
            for (int j = 0; j < 8; ++j) sa += S[j] * avs[t * 64 + 8 * kq + j];
            sa += __shfl_xor(sa, 1); sa += __shfl_xor(sa, 2); sa += __shfl_xor(sa, 4);
            const float vv = vs[t * 64 + i]; float y = 0.f;
#pragma unroll
            for (int j = 0; j < 8; ++j) { const int c = t * 64 + 8 * kq + j; S[j] = S[j] * wsd[c] + sa * bvs[c] + vv * k2s[c]; y += S[j] * rs[c]; }
            y += __shfl_xor(y, 1); y += __shfl_xor(y, 2); y += __shfl_xor(y, 4);
            if (kq == 0) yb[t * 64 + i] = y;
        }
        __syncthreads();
        for (int q = 0; q < 4; ++q) { const int t = wave * 4 + q; const size_t m = (size_t)(b * T + t0 + t);
            const float y = yb[t * 64 + lane]; const float mean = wave_sum(y) * (1.0f / 64.0f); const float dv = y - mean; const float var = wave_sum(dv * dv) * (1.0f / 64.0f);
            const float yn = dv * (1.0f / sqrtf(var + 64e-5f)) * lng + lnb;
            mix[m * K_OOUT + 1024 + hc] = (bf16)f2bf((yn + bsum[t] * vs[t * 64 + lane]) * GG[m * 512 + hc]); }
        __syncthreads();
    }
}

struct Args { const float* in[47]; float* out; unsigned char* ws; };
__global__ void __launch_bounds__(NWAVES * 64, 2) fwd_kernel(Args args) {
    extern __shared__ __attribute__((aligned(16))) unsigned char lds_raw[];
    LAS unsigned char* lds = (LAS unsigned char*)lds_raw;
    volatile LAS unsigned* MISC = (volatile LAS unsigned*)(lds + MISC_OFF);
    LAS int* PE = (LAS int*)(lds + PE_OFF);
    LAS float* Lf = (LAS float*)(lds + RING_OFF);
    const int tid = threadIdx.x, lane = tid & 63, wave = __builtin_amdgcn_readfirstlane(tid >> 6);
    const int G = gridDim.x, bid = blockIdx.x, gw = bid * NWAVES + wave, NGW = G * NWAVES;
    unsigned char* ws = args.ws; const float* const* in = args.in;
    gu32* ctl = (gu32*)(ws + WS_CTL);
    for (int u = tid; u < (LDS_BYTES - LDSCTL_OFF) / 4; u += NWAVES * 64) ((LAS unsigned*)(lds + LDSCTL_OFF))[u] = 0u;
    __syncthreads();
    XcdBarrier bar = xcd_barrier_post((unsigned*)(ctl + CW_BAR), MISC + 8);
#define GRID_BAR() xcd_barrier(bar)
    bf16* XBF = (bf16*)(ws + WS_XBF); bf16* PB = (bf16*)(ws + WS_P); float* Y = (float*)(ws + WS_Y);

#if !defined(ONLY) || ONLY==0
    {
        LAS float* scr = Lf + wave * (64 * 33);
        for (int it = gw; it < IT_SMALL; it += NGW) cvt_small_item(in, ws, it, scr, lane);
        bf16* WE = (bf16*)(ws + WS_WEIN);
        for (int idx = bid * 512 + tid; idx < 256 * 1024; idx += G * 512) { const int k = idx & 1023, n = idx >> 10; float s = 0.f;
#pragma unroll
            for (int r = 0; r < 16; ++r) s += in[1][(size_t)k * 2576 + 1536 + r] * in[2][r * 256 + n];
            WE[(size_t)(E_GK + n) * D + k] = (bf16)f2bf(s); }
        for (size_t idx = (size_t)bid * 512 + tid; idx < (size_t)M * D / 4; idx += (size_t)G * 512) { const f32x4 v = ((const GAS f32x4*)in[0])[idx]; v2u o; o.x = pk2(v.x, v.y); o.y = pk2(v.z, v.w); ((GAS v2u*)XBF)[idx] = o; }
    }
    GRID_BAR();
#endif
#if !defined(ONLY) || ONLY==1
    { pg8::Gemm g{XBF, (const bf16*)(ws + WS_WEIN), M, N_EIN, D}; pg8::StaticOrder S; S.init(M, N_EIN, G, bid); pg8::EpiStoreBf16 E{PB, N_EIN};
      pg8::gemm_phase<pg8::EpiStoreBf16, pg8::StaticOrder, true, true>(lds + RING_OFF, g, S, E); }
    GRID_BAR();
#endif
#if !defined(ONLY) || ONLY==2
    for (int it = bid; it < 96; it += G) { if (it < 32) gla_item(in, ws, Lf, it, tid); else lru_item(in, ws, Lf, it - 32, tid); }
    GRID_BAR();
#endif
#if !defined(ONLY) || ONLY==3
    { pg8::Gemm g{(const bf16*)(ws + WS_MIX0), (const bf16*)(ws + WS_WEOUT), M, D, D}; pg8::StaticOrder S; S.init(M, D, G, bid); pg8::EpiStoreF32 E{Y, D};
      pg8::gemm_phase<pg8::EpiStoreF32, pg8::StaticOrder, true, true>(lds + RING_OFF, g, S, E); }
    GRID_BAR();
#endif
#if !defined(ONLY) || ONLY==4
    ln_rows<0>(in[0], Y, in[13], in[14], args.out, XBF, nullptr, ws, ctl, gw, NGW, lane);
    GRID_BAR();
#endif
#if !defined(ONLY) || ONLY==5
    { pg8::Gemm g{XBF, (const bf16*)(ws + WS_WF13), M, N_F13, D}; pg8::StaticOrder S; S.init(M, N_F13, G, bid); pg8::EpiSwiGLU E{PB, FF};
      pg8::gemm_phase<pg8::EpiSwiGLU, pg8::StaticOrder, true, true>(lds + RING_OFF, g, S, E); }
    GRID_BAR();
#endif
#if !defined(ONLY) || ONLY==6
    { pg8::Gemm g{PB, (const bf16*)(ws + WS_WF2), M, D, FF}; pg8::StaticOrder S; S.init(M, D, G, bid); pg8::EpiStoreF32 E{Y, D};
      pg8::gemm_phase<pg8::EpiStoreF32, pg8::StaticOrder, true, true>(lds + RING_OFF, g, S, E); }
    GRID_BAR();
#endif
#if !defined(ONLY) || ONLY==7
    ln_rows<0>(args.out, Y, in[18], in[19], args.out, XBF, nullptr, ws, ctl, gw, NGW, lane);
    GRID_BAR();
#endif
#if !defined(ONLY) || ONLY==8
    { pg8::Gemm g{XBF, (const bf16*)(ws + WS_WOIN), M, N_OIN, D}; pg8::StaticOrder S; S.init(M, N_OIN, G, bid); pg8::EpiStoreBf16 E{PB, N_OIN};
      pg8::gemm_phase<pg8::EpiStoreBf16, pg8::StaticOrder, true, true>(lds + RING_OFF, g, S, E); }
    GRID_BAR();
#endif
#if !defined(ONLY) || ONLY==9
    if (bid < 128 && G >= 256) ssd_item(in, ws, Lf, bid, tid);
    else if (G >= 256) { for (int tl = bid - 128; tl < 512; tl += G - 128) rwkv_pre_tile(in, ws, Lf, tl, tid); }
    else { for (int it = bid; it < 128; it += G) ssd_item(in, ws, Lf, it, tid); for (int tl = bid; tl < 512; tl += G) rwkv_pre_tile(in, ws, Lf, tl, tid); }
    GRID_BAR();
#endif
#if !defined(ONLY) || ONLY==10
    if (G >= 128) { if (bid < 64) rwkv_item(in, ws, Lf, bid, tid); else ssd_norm_rows(in, ws, (bid - 64) * NWAVES + wave, (G - 64) * NWAVES, lane); }
    else { for (int it = bid; it < 64; it += G) rwkv_item(in, ws, Lf, it, tid); ssd_norm_rows(in, ws, gw, NGW, lane); }
    GRID_BAR();
#endif
#if !defined(ONLY) || ONLY==11
    { pg8::Gemm g{(const bf16*)(ws + WS_MIX1), (const bf16*)(ws + WS_WOOUT), M, D, K_OOUT}; pg8::StaticOrder S; S.init(M, D, G, bid); pg8::EpiStoreF32 E{Y, D};
      pg8::gemm_phase<pg8::EpiStoreF32, pg8::StaticOrder, true, true>(lds + RING_OFF, g, S, E); }
    { LAS float* scr = Lf + wave * (64 * 33);
      for (int it = gw; it < IT_EXP; it += NGW) cvt_exp_item(in, ws, it, scr, lane); }
    GRID_BAR();
#endif
#if !defined(ONLY) || ONLY==12
    ln_rows<1>(args.out, Y, in[39], in[40], args.out, XBF, in[41], ws, ctl, gw, NGW, lane);
    GRID_BAR();
#endif
#if !defined(ONLY) || ONLY==13
    {
        if (tid == 0) { int off = 0;
            for (int e = 0; e < NE; ++e) { const int c = (int)__hip_atomic_load(ctl + CW_CNT + 64 * e, RLX_AGENT); const int np = (c + 255) >> 8; PE[160 + e] = off; for (int p = off; p < off + np && p < 160; ++p) PE[p] = e; off += np; }
            PE[168] = off; PE[169] = off; for (int p = off; p < 160; ++p) PE[p] = 0; }
        __syncthreads();
        const int* re = (const int*)(ws + WS_ROUTE + RT_E); const int* rp = (const int*)(ws + WS_ROUTE + RT_P); int* rdst = (int*)(ws + WS_ROUTE + RT_DST); bf16* XY = (bf16*)(ws + WS_XY);
        for (int pr = gw; pr < 2 * M; pr += NGW) { const int e = re[pr], dst = PE[160 + e] * 256 + rp[pr]; const int m = pr >> 1;
            const GAS v4u* src = (const GAS v4u*)(XBF + (size_t)m * D) + lane; GAS v4u* dp = (GAS v4u*)(XY + (size_t)dst * D) + lane;
            dp[0] = src[0]; dp[64] = src[64]; if (lane == 0) rdst[pr] = dst; }
        for (int e = 0; e < NE; ++e) { const int c = (int)__hip_atomic_load(ctl + CW_CNT + 64 * e, RLX_AGENT); const int r0 = PE[160 + e] * 256 + c, r1 = PE[160 + e] * 256 + (((c + 255) >> 8) << 8);
            for (int r = r0 + gw; r < r1; r += NGW) { GAS v4u* dp = (GAS v4u*)(XY + (size_t)r * D) + lane; dp[0] = (v4u){0u, 0u, 0u, 0u}; dp[64] = (v4u){0u, 0u, 0u, 0u}; } }
    }
    GRID_BAR();
#endif
#ifndef NO_MOE
#if !defined(ONLY) || ONLY==14
    {
        const int NP = PE[169]; const int nchunks = (NP + MOE_CP - 1) / MOE_CP;
        for (int c = 0; c <= nchunks; ++c) {
            const int np_up = c < nchunks ? min(MOE_CP, NP - c * MOE_CP) : 0, np_dn = c > 0 ? min(MOE_CP, NP - (c - 1) * MOE_CP) : 0;
            const int nu = np_up * 28, nd = np_dn * 4;
            int Lv = (7 * nd + 2 * nu + G - 1) / G; if (Lv < 0) Lv = 0;
            for (;;) { const int qa_ = Lv > 7 ? (Lv - 7) / 2 : 0, qb_ = Lv / 2; if ((long)nd * qa_ + (long)(G - nd) * qb_ >= nu) break; ++Lv; }
            const int qa = Lv > 7 ? (Lv - 7) / 2 : 0, qb = Lv / 2;
            const int ndc = nd < G ? nd : G;
            const int ustart = bid < ndc ? bid * qa : ndc * qa + (bid - ndc) * qb; int ucount = bid < ndc ? qa : qb; if (ustart + ucount > nu) ucount = nu - ustart; if (ucount < 0) ucount = 0;
            bf16* HEup = (bf16*)(ws + WS_HE + (size_t)(c & 1) * HE_BYTES); const bf16* HEdn = (const bf16*)(ws + WS_HE + (size_t)((c + 1) & 1) * HE_BYTES);
            if (nd > 0) { pg8::Gemm g{HEdn, (const bf16*)(ws + WS_EXP2), 0, D, FE}; pg8::MoeDownOrder S{bid, 0, (c - 1) * MOE_CP, PE};
                int cnt = 0; for (int d = bid; d < nd; d += G) ++cnt; S.count = cnt;
                pg8::EpiStoreBf16 E{(bf16*)(ws + WS_XY), D};
                pg8::gemm_phase<pg8::EpiStoreBf16, pg8::MoeDownOrder, true, true>(lds + RING_OFF, g, S, E); }
            if (nu > 0) { pg8::Gemm g{(const bf16*)(ws + WS_XY), (const bf16*)(ws + WS_EXP13), 0, N_E13, D}; pg8::MoeUpOrder S{ustart, ucount, c * MOE_CP, PE};
                pg8::EpiSwiGLU E{HEup, FE};
                pg8::gemm_phase<pg8::EpiSwiGLU, pg8::MoeUpOrder, true, true>(lds + RING_OFF, g, S, E); }
            GRID_BAR();
        }
    }
#endif
#endif
    ln_rows<2>(args.out, nullptr, in[45], in[46], args.out, nullptr, nullptr, ws, ctl, gw, NGW, lane);
}

extern "C" void kernel_launch(void* const* d_in, const int* in_sizes, int n_in, void* d_out, int out_size, void* d_ws, size_t ws_size, hipStream_t stream) {
    static int grid = 0;
    if (grid == 0) {
        if (n_in != 47 || in_sizes[0] != M * D || out_size != M * D || ws_size < WS_END) { fprintf(stderr, "kernel_launch: unexpected shapes (n_in %d, out %d, ws %zu)\n", n_in, out_size, ws_size); grid = -1; return; }
        int dev = 0, cus = 0, per_cu = 0;
        if (hipGetDevice(&dev) != hipSuccess || hipDeviceGetAttribute(&cus, hipDeviceAttributeMultiprocessorCount, dev) != hipSuccess) { grid = -1; return; }
        if (hipFuncSetAttribute((const void*)fwd_kernel, hipFuncAttributeMaxDynamicSharedMemorySize, LDS_BYTES) != hipSuccess) { fprintf(stderr, "kernel_launch: hipFuncSetAttribute failed\n"); grid = -1; return; }
        if (hipOccupancyMaxActiveBlocksPerMultiprocessor(&per_cu, (const void*)fwd_kernel, NWAVES * 64, LDS_BYTES) != hipSuccess || per_cu < 1) { fprintf(stderr, "kernel_launch: occupancy query reports %d\n", per_cu); }
        (void)hipGetLastError();
        grid = cus;
    }
    if (grid < 0) return;
    if (hipMemsetAsync((char*)d_ws + WS_CTL, 0, CTL_ZERO_BYTES, stream) != hipSuccess) return;
    Args a{};
    for (int i = 0; i < 47; ++i) a.in[i] = (const float*)d_in[i];
    a.out = (float*)d_out; a.ws = (unsigned char*)d_ws;
    hipLaunchKernelGGL(fwd_kernel, dim3(grid), dim3(NWAVES * 64), LDS_BYTES, stream, a);
}
```

```cpp
#include <hip/hip_runtime.h>
#include <cstdio>
#include <cstdint>
#include <cmath>
namespace pg8 {
#define PG8_LAS __attribute__((address_space(3)))
typedef unsigned short bf16_t;
typedef short bf16x8 __attribute__((ext_vector_type(8)));
typedef float f32x4 __attribute__((ext_vector_type(4)));
typedef unsigned u32x4 __attribute__((ext_vector_type(4)));
constexpr int BM = 256, BK = 64, HALF = 128, HTB = HALF * BK * 2  , STAGE_BYTES = 8 * HTB, NXCD = 8, WGM = 8;

__host__ __device__ __forceinline__ int lds_byte(int r, int c) { const int st = (r >> 4) * 2 + (c >> 5), rr = r & 15, cc = c & 31, ob = rr * 64 + cc * 2; return st * 1024 + (ob ^ (((ob >> 9) & 1) << 5)); }
__host__ __device__ __forceinline__ void stage_rc(int b, int& R, int& C) { const int st = b / 1024, sb = b % 1024, swz = sb ^ (((sb >> 9) & 1) << 5); R = (st >> 1) * 16 + swz / 64; C = (st & 1) * 32 + (swz % 64) / 2; }
__host__ __device__ __forceinline__ int perm32(int rho) { const int n = rho >> 4, i = rho & 15; return 8 * (i >> 2) + 4 * n + (i & 3); }

struct Unit { int pm, pn, om, on; };
struct Gemm { const bf16_t* A; const bf16_t* Bt; int M, N, K; };

struct StaticOrder {
    int nM, nN, nwg, G, c;
    __host__ __device__ void init(int M, int N, int G_, int c_) { nM = M / BM; nN = N / BM; nwg = nM * nN; G = G_; c = c_; }
    __host__ __device__ bool next(int i, Unit& u) const {
        const long L = (long)i * G + c; if (L >= nwg) return false;
        int wgid = (int)L; { const int q = nwg / NXCD, r = nwg % NXCD, xcd = wgid % NXCD, off = wgid / NXCD; wgid = (xcd < r ? xcd * (q + 1) : r * (q + 1) + (xcd - r) * q) + off; }
        const int nig = WGM * nN, gid = wgid / nig, fm = gid * WGM, gsz = (nM - fm) < WGM ? (nM - fm) : WGM;
        u.pm = fm + ((wgid % nig) % gsz); u.pn = (wgid % nig) / gsz; u.om = u.pm; u.on = u.pn; return true;
    }
    __device__ __forceinline__ void a_ready(const Unit&) const {}
    __device__ __forceinline__ void done(const Unit&) const {}
};
struct MoeUpOrder {
    int start, count, pbase; const PG8_LAS int* pe;
    __device__ __forceinline__ bool next(int i, Unit& u) const { if (i >= count) return false; const int k = start + i, pl = k / 28, j = k - pl * 28, p = pbase + pl, e = pe[p];
        u.pm = p; u.pn = e * 28 + j; u.om = pl; u.on = j; return true; }
    __device__ __forceinline__ void a_ready(const Unit&) const {}
    __device__ __forceinline__ void done(const Unit&) const {}
};
struct MoeDownOrder {
    int start, count, pbase; const PG8_LAS int* pe;
    __device__ __forceinline__ bool next(int i, Unit& u) const { if (i >= count) return false; const int d = start + i, pl = d >> 2, j = d & 3, p = pbase + pl, e = pe[p];
        u.pm = pl; u.pn = e * 4 + j; u.om = p; u.on = j; return true; }
    __device__ __forceinline__ void a_ready(const Unit&) const {}
    __device__ __forceinline__ void done(const Unit&) const {}
};

__device__ __forceinline__ unsigned cvt_pk_bf16(float lo, float hi) { unsigned r; asm volatile("v_cvt_pk_bf16_f32 %0, %1, %2" : "=v"(r) : "v"(lo), "v"(hi)); return r; }

struct EpiStoreF32 {
    static constexpr bool PERM = false, AFTER_DRAIN = false;
    float* C; int ldc;
    __device__ __forceinline__ void operator()(const f32x4 (&acc)[2][2][4][2], const Unit& u, int wr, int wc, int fr, int fq) const {
        const int row0 = u.om * BM + wr * 64 + fr, col0 = u.on * BM + wc * 32 + 4 * fq;
#pragma unroll
        for (int ai = 0; ai < 2; ++ai)
#pragma unroll
            for (int m = 0; m < 4; ++m) { float* rowp = C + (size_t)(row0 + ai * HALF + m * 16) * ldc + col0;
#pragma unroll
                for (int bj = 0; bj < 2; ++bj)
#pragma unroll
                    for (int n = 0; n < 2; ++n) *(f32x4*)(rowp + bj * HALF + n * 16) = acc[ai][bj][m][n]; }
    }
};
struct EpiStoreBf16 {
    static constexpr bool PERM = true, AFTER_DRAIN = false;
    bf16_t* O; int ldc;
    __device__ __forceinline__ void operator()(const f32x4 (&acc)[2][2][4][2], const Unit& u, int wr, int wc, int fr, int fq) const {
        const int row0 = u.om * BM + wr * 64 + fr, col0 = u.on * BM + wc * 32 + 8 * fq;
#pragma unroll
        for (int ai = 0; ai < 2; ++ai)
#pragma unroll
            for (int m = 0; m < 4; ++m) { bf16_t* rowp = O + (size_t)(row0 + ai * HALF + m * 16) * ldc + col0;
#pragma unroll
                for (int bj = 0; bj < 2; ++bj) { const f32x4 v0 = acc[ai][bj][m][0], v1 = acc[ai][bj][m][1];
                    u32x4 w; w.x = cvt_pk_bf16(v0[0], v0[1]); w.y = cvt_pk_bf16(v0[2], v0[3]); w.z = cvt_pk_bf16(v1[0], v1[1]); w.w = cvt_pk_bf16(v1[2], v1[3]);
                    *(u32x4*)(rowp + bj * HALF) = w; } }
    }
};
__device__ __forceinline__ float silu_f(float x) { return x * __builtin_amdgcn_rcpf(1.0f + __builtin_amdgcn_exp2f(-1.4426950408889634f * x)); }
struct EpiSwiGLU {
    static constexpr bool PERM = true, AFTER_DRAIN = false;
    bf16_t* O; int ldc;
    __device__ __forceinline__ void operator()(const f32x4 (&acc)[2][2][4][2], const Unit& u, int wr, int wc, int fr, int fq) const {
        const int row0 = u.om * BM + wr * 64 + fr, col0 = u.on * HALF + wc * 32 + 8 * fq;
#pragma unroll
        for (int ai = 0; ai < 2; ++ai)
#pragma unroll
            for (int m = 0; m < 4; ++m) { bf16_t* rowp = O + (size_t)(row0 + ai * HALF + m * 16) * ldc + col0;
                const f32x4 g0 = acc[ai][0][m][0], g1 = acc[ai][0][m][1], u0 = acc[ai][1][m][0], u1 = acc[ai][1][m][1];
                u32x4 w; w.x = cvt_pk_bf16(silu_f(g0[0]) * u0[0], silu_f(g0[1]) * u0[1]); w.y = cvt_pk_bf16(silu_f(g0[2]) * u0[2], silu_f(g0[3]) * u0[3]);
                w.z = cvt_pk_bf16(silu_f(g1[0]) * u1[0], silu_f(g1[1]) * u1[1]); w.w = cvt_pk_bf16(silu_f(g1[2]) * u1[2], silu_f(g1[3]) * u1[3]);
                *(u32x4*)rowp = w; }
    }
};

template <class Epi, class Sched, bool ALIGN_EPI = false, bool SP2 = false>
__device__ __forceinline__ void gemm_phase(PG8_LAS unsigned char* lds, const Gemm g, const Sched& S, const Epi& E) {
    const int tid = threadIdx.x, wid = __builtin_amdgcn_readfirstlane(tid >> 6), lane = tid & 63, wr = wid >> 2, wc = wid & 3, fr = lane & 15, fq = lane >> 4;
    const int K = g.K, nt = K / BK;
    unsigned voffA[2], voffB[2];
#pragma unroll
    for (int i = 0; i < 2; ++i) { int R, C; stage_rc(tid * 16 + i * 8192, R, C); const int Rb = Epi::PERM ? ((R & ~31) + perm32(R & 31)) : R;
        voffA[i] = (unsigned)(R * K + C) * 2u; voffB[i] = (unsigned)(Rb * K + C) * 2u; }
    const size_t kstep = (size_t)(BK * 2);
    const size_t hstep = (size_t)HALF * K * 2;
    const size_t tstep = 2 * hstep;
    const unsigned ldsw = (unsigned)wid * 1024u;
    const int aoff = lds_byte(wr * 64 + fr, fq * 8), boff = lds_byte(wc * 32 + fr, fq * 8);
#define PG8_SA(b, h) (((b) * 2 + (h)) * HTB)
#define PG8_SB(b, h) ((4 + (b) * 2 + (h)) * HTB)
#define PG8_STAGE(bufoff, gbase, voff) do { _Pragma("unroll") for (int _i = 0; _i < 2; ++_i) \
        __builtin_amdgcn_global_load_lds((const unsigned*)((const char*)(gbase) + (voff)[_i]), (PG8_LAS unsigned*)(lds + (bufoff) + ldsw + _i * 8192), 16, 0, 0); } while (0)
#define PG8_LDA(dst, b, h) do { _Pragma("unroll") for (int m = 0; m < 4; ++m) _Pragma("unroll") for (int k = 0; k < 2; ++k) dst[m][k] = *(const PG8_LAS bf16x8*)(lds + PG8_SA(b, h) + aoff + m * 2048 + k * 1024); } while (0)
#define PG8_LDB(dst, b, h) do { _Pragma("unroll") for (int n = 0; n < 2; ++n) _Pragma("unroll") for (int k = 0; k < 2; ++k) dst[n][k] = *(const PG8_LAS bf16x8*)(lds + PG8_SB(b, h) + boff + n * 2048 + k * 1024); } while (0)
#define PG8_MMA(ai, bj, At, Bt) do { __builtin_amdgcn_s_setprio(1); _Pragma("unroll") for (int m = 0; m < 4; ++m) _Pragma("unroll") for (int n = 0; n < 2; ++n) _Pragma("unroll") for (int k = 0; k < 2; ++k) \
        acc[ai][bj][m][n] = __builtin_amdgcn_mfma_f32_16x16x32_bf16(Bt[n][k], At[m][k], acc[ai][bj][m][n], 0, 0, 0); __builtin_amdgcn_s_setprio(0); } while (0)
#define PG8_WAIT_V(n) asm volatile("s_waitcnt vmcnt(" #n ")" ::: "memory")
#define PG8_WAIT_L(n) asm volatile("s_waitcnt lgkmcnt(" #n ")" ::: "memory")
#define PG8_BAR __builtin_amdgcn_s_barrier()
#define PG8_SCHED __builtin_amdgcn_sched_barrier(0)
    Unit cur, nxt; int ui = 0;
    if (!S.next(0, cur)) return;
    f32x4 acc[2][2][4][2];
#pragma unroll
    for (int a = 0; a < 2; ++a)
#pragma unroll
        for (int b = 0; b < 2; ++b)
#pragma unroll
            for (int m = 0; m < 4; ++m)
#pragma unroll
                for (int n = 0; n < 2; ++n) acc[a][b][m][n] = (f32x4){0.f, 0.f, 0.f, 0.f};
    bf16x8 At[4][2], B0[2][2], B1[2][2];
    const char* cA = (const char*)g.A + (size_t)cur.pm * tstep; const char* cB = (const char*)g.Bt + (size_t)cur.pn * tstep;
    S.a_ready(cur);
    if constexpr (SP2) {
        PG8_STAGE(PG8_SB(0, 0), cB, voffB); PG8_STAGE(PG8_SB(0, 1), cB + hstep, voffB); PG8_STAGE(PG8_SA(0, 0), cA, voffA); PG8_STAGE(PG8_SA(0, 1), cA + hstep, voffA);
        if (wr == 1) PG8_BAR;
        PG8_WAIT_V(2); PG8_BAR;
        PG8_STAGE(PG8_SB(1, 0), cB + kstep, voffB); PG8_STAGE(PG8_SA(1, 0), cA + kstep, voffA); PG8_STAGE(PG8_SB(1, 1), cB + hstep + kstep, voffB);
        PG8_WAIT_V(6); PG8_BAR;
    } else {
        PG8_STAGE(PG8_SB(0, 0), cB, voffB); PG8_STAGE(PG8_SA(0, 0), cA, voffA); PG8_STAGE(PG8_SB(0, 1), cB + hstep, voffB); PG8_STAGE(PG8_SA(0, 1), cA + hstep, voffA);
        if (wr == 1) PG8_BAR;
        PG8_WAIT_V(4); PG8_BAR;
        PG8_STAGE(PG8_SB(1, 0), cB + kstep, voffB); PG8_STAGE(PG8_SA(1, 0), cA + kstep, voffA); PG8_STAGE(PG8_SB(1, 1), cB + hstep + kstep, voffB);
        PG8_WAIT_V(6); PG8_BAR;
    }
    for (;;) {
        const bool has_next = S.next(ui + 1, nxt);
        const char* nA = has_next ? (const char*)g.A + (size_t)nxt.pm * tstep : cA; const char* nB = has_next ? (const char*)g.Bt + (size_t)nxt.pn * tstep : cB;
        for (int t = 0; t < nt; t += 2) {
            const bool last = (t == nt - 2);
            const char* a1 = cA + (size_t)(t + 1) * kstep;
            const char* a2 = last ? nA : cA + (size_t)(t + 2) * kstep; const char* b2 = last ? nB : cB + (size_t)(t + 2) * kstep;
            const char* a3 = a2 + kstep; const char* b3 = b2 + kstep;
            if (last && has_next) S.a_ready(nxt);
            if constexpr (SP2) {
            PG8_LDB(B0, 0, 0); PG8_LDB(B1, 0, 1); PG8_SCHED; PG8_LDA(At, 0, 0); PG8_STAGE(PG8_SA(1, 1), a1 + hstep, voffA);
            PG8_WAIT_V(8); PG8_WAIT_L(0); PG8_BAR; PG8_MMA(0, 0, At, B0); PG8_MMA(0, 1, At, B1); PG8_BAR; PG8_SCHED;
            PG8_LDA(At, 0, 1); PG8_STAGE(PG8_SB(0, 0), b2, voffB); PG8_STAGE(PG8_SB(0, 1), b2 + hstep, voffB); PG8_STAGE(PG8_SA(0, 0), a2, voffA);
            PG8_WAIT_V(8); PG8_WAIT_L(0); PG8_BAR; PG8_MMA(1, 0, At, B0); PG8_MMA(1, 1, At, B1); PG8_BAR; PG8_SCHED;
            PG8_LDB(B0, 1, 0); PG8_LDB(B1, 1, 1); PG8_SCHED; PG8_LDA(At, 1, 0); PG8_STAGE(PG8_SA(0, 1), a2 + hstep, voffA);
            PG8_WAIT_V(8); PG8_WAIT_L(0); PG8_BAR; PG8_MMA(0, 0, At, B0); PG8_MMA(0, 1, At, B1); PG8_BAR; PG8_SCHED;
            PG8_LDA(At, 1, 1); PG8_STAGE(PG8_SB(1, 0), b3, voffB); PG8_STAGE(PG8_SB(1, 1), b3 + hstep, voffB); PG8_STAGE(PG8_SA(1, 0), a3, voffA);
            PG8_WAIT_V(8); PG8_WAIT_L(0); PG8_BAR; PG8_MMA(1, 0, At, B0); PG8_MMA(1, 1, At, B1); PG8_BAR; PG8_SCHED;
            } else {
            PG8_LDB(B0, 0, 0); PG8_SCHED; PG8_LDA(At, 0, 0); PG8_STAGE(PG8_SA(1, 1), a1 + hstep, voffA);
            PG8_WAIT_L(8); PG8_BAR; PG8_WAIT_L(0); PG8_MMA(0, 0, At, B0); PG8_BAR; PG8_SCHED;
            PG8_LDB(B1, 0, 1); PG8_STAGE(PG8_SB(0, 0), b2, voffB);
            PG8_BAR; PG8_WAIT_L(0); PG8_MMA(0, 1, At, B1); PG8_BAR;
            PG8_LDA(At, 0, 1); PG8_STAGE(PG8_SA(0, 0), a2, voffA);
            PG8_BAR; PG8_WAIT_L(0); PG8_MMA(1, 0, At, B0); PG8_BAR; PG8_SCHED;
            PG8_STAGE(PG8_SB(0, 1), b2 + hstep, voffB);
            PG8_WAIT_V(6); PG8_BAR; PG8_MMA(1, 1, At, B1); PG8_BAR;
            PG8_LDB(B0, 1, 0); PG8_SCHED; PG8_LDA(At, 1, 0); PG8_STAGE(PG8_SA(0, 1), a2 + hstep, voffA);
            PG8_WAIT_L(8); PG8_BAR; PG8_WAIT_L(0); PG8_MMA(0, 0, At, B0); PG8_BAR; PG8_SCHED;
            PG8_LDB(B1, 1, 1); PG8_STAGE(PG8_SB(1, 0), b3, voffB);
            PG8_BAR; PG8_WAIT_L(0); PG8_MMA(0, 1, At, B1); PG8_BAR;
            PG8_LDA(At, 1, 1); PG8_STAGE(PG8_SA(1, 0), a3, voffA);
            PG8_BAR; PG8_WAIT_L(0); PG8_MMA(1, 0, At, B0); PG8_BAR; PG8_SCHED;
            PG8_STAGE(PG8_SB(1, 1), b3 + hstep, voffB);
            PG8_WAIT_V(6); PG8_BAR; PG8_MMA(1, 1, At, B1); PG8_BAR;
            }
        }
        if constexpr (ALIGN_EPI) { if (wr == 0) PG8_BAR; }
        if constexpr (!Epi::AFTER_DRAIN) { E(acc, cur, wr, wc, fr, fq); S.done(cur); }
        if (!has_next) break;
#pragma unroll
        for (int a = 0; a < 2; ++a)
#pragma unroll
            for (int b = 0; b < 2; ++b)
#pragma unroll
                for (int m = 0; m < 4; ++m)
#pragma unroll
                    for (int n = 0; n < 2; ++n) acc[a][b][m][n] = (f32x4){0.f, 0.f, 0.f, 0.f};
        cur = nxt; cA = nA; cB = nB; ++ui;
        if constexpr (ALIGN_EPI) { if (wr == 1) PG8_BAR; }
    }
    PG8_WAIT_V(0);
    if constexpr (!ALIGN_EPI) { if (wr == 0) PG8_BAR; }
    PG8_BAR;
    if constexpr (Epi::AFTER_DRAIN) { E.fused(acc, cur, wr, wc, fr, fq, lds, wid, lane); S.done(cur); }
#undef PG8_SA
#undef PG8_SB
#undef PG8_STAGE
#undef PG8_LDA
#undef PG8_LDB
#undef PG8_MMA
#undef PG8_WAIT_V
#undef PG8_WAIT_L
#undef PG8_BAR
#undef PG8_SCHED
}
}

constexpr int NB = 8, T = 2048, D = 1024, M = NB * T;
constexpr int N_EIN = 2816;
constexpr int E_Q = 0, E_K = 256, E_V = 512, E_G = 1024, E_GK = 1536, E_XB = 1792, E_GATE = 2304;
constexpr int FF = 2816, N_F13 = 2 * FF;
constexpr int N_OIN = 4608;
constexpr int O_Z = 0, O_XS = 1024, O_B = 2048, O_C = 2304, O_R = 2560, O_DT = 4352;
constexpr int K_OOUT = 1536, NE = 8, FE = 3584, N_E13 = 2 * FE  ;
constexpr int MOE_MAXP = 136, MOE_CP = 32;
constexpr float LN_EPS = 1e-5f, ALPHA = 1.4142135623730951f;

constexpr size_t MiB = 1u << 20;
constexpr size_t WS_CTL = 0, CTL_ZERO_BYTES = 1 * MiB;
constexpr size_t WS_WEIN = 1 * MiB;
constexpr size_t WS_WEOUT = WS_WEIN + (size_t)N_EIN * D * 2;
constexpr size_t WS_WF13 = WS_WEOUT + (size_t)D * D * 2;
constexpr size_t WS_WF2 = WS_WF13 + (size_t)N_F13 * D * 2;
constexpr size_t WS_WOIN = WS_WF2 + (size_t)D * FF * 2;
constexpr size_t WS_WOOUT = WS_WOIN + (size_t)N_OIN * D * 2;
constexpr size_t WS_ROUTE = 37 * MiB;
constexpr size_t WS_EXP13 = 38 * MiB;
constexpr size_t WS_EXP2 = 150 * MiB;
constexpr size_t WS_DEC = 38 * MiB, WS_AA = 70 * MiB, WS_GG = 102 * MiB, WS_SSDY = 134 * MiB;
constexpr size_t WS_YRAW = 198 * MiB, WS_BS = 230 * MiB;
constexpr size_t WS_XBF = 206 * MiB;
constexpr size_t WS_P = 238 * MiB;
constexpr size_t WS_MIX0 = 326 * MiB;
constexpr size_t WS_Y = 358 * MiB;
constexpr size_t WS_MIX1 = 422 * MiB;
constexpr size_t WS_XY = 238 * MiB;
constexpr size_t WS_HE = 306 * MiB, HE_BYTES = (size_t)MOE_CP * 256 * FE * 2;
constexpr size_t WS_END = 470 * MiB;
static_assert(WS_WOOUT + (size_t)D * K_OOUT * 2 <= WS_ROUTE && WS_P + (size_t)M * N_OIN * 2 <= WS_MIX1 && WS_HE + 2 * HE_BYTES <= WS_MIX1 && WS_MIX1 + (size_t)M * K_OOUT * 2 <= WS_END, "d_ws map");
static_assert(WS_XY + (size_t)MOE_MAXP * 256 * D * 2 <= WS_HE && WS_EXP2 + (size_t)NE * D * FE * 2 <= WS_XBF && WS_SSDY + (size_t)M * D * 4 <= WS_XBF, "d_ws map 2");
constexpr size_t RT_E = 0, RT_P = 128 * 1024, RT_W = 256 * 1024, RT_DST = 384 * 1024;
constexpr int CW_TMO = 0, CW_CODE = 1, CW_BAR = 4096, CW_CNT = 16384;

constexpr int NWAVES = 8;
constexpr int RING_OFF = 0, RING_BYTES = 131072;
constexpr int LDS_BYTES = 147456;
constexpr int LDSCTL_OFF = LDS_BYTES - 2048, MISC_OFF = LDSCTL_OFF + 320, PE_OFF = MISC_OFF + 128;
static_assert(PE_OFF + 4 * 192 <= LDS_BYTES, "LDS map");

#define GAS __attribute__((address_space(1)))
#define LAS __attribute__((address_space(3)))
typedef unsigned short bf16;
typedef unsigned v4u __attribute__((ext_vector_type(4)));
typedef unsigned v2u __attribute__((ext_vector_type(2)));
typedef float f32x4 __attribute__((ext_vector_type(4)));
typedef GAS unsigned gu32;
#define RLX_AGENT __ATOMIC_RELAXED, __HIP_MEMORY_SCOPE_AGENT
#define LDS_WAIT() asm volatile("s_waitcnt lgkmcnt(0)" ::: "memory")
#define VM_WAIT() asm volatile("s_waitcnt vmcnt(0)" ::: "memory")
__device__ __forceinline__ unsigned f2bf(float f) { unsigned u = __builtin_bit_cast(unsigned, f); return (u + 0x7fffu + ((u >> 16) & 1u)) >> 16; }
__device__ __forceinline__ unsigned pk2(float lo, float hi) { return f2bf(lo) | (f2bf(hi) << 16); }

#define XB_TMO      128
#define XB_XCNT(j)  (256  + 64 * (j))
#define XB_XSUB(j)  (1280 + 64 * (j))
#define XB_XGEN(j)  (2304 + 64 * (j))
#define XB_TOP      3328
#define XB_TOPGEN   3392
#define XCD_BAR_WORDS 3456
#define XB_SPIN_CAP (1u << 18)

__device__ __forceinline__ unsigned xb_ld(unsigned* p)              { return __hip_atomic_load(p, __ATOMIC_RELAXED, __HIP_MEMORY_SCOPE_AGENT); }
__device__ __forceinline__ unsigned xb_add(unsigned* p, unsigned v) { return __hip_atomic_fetch_add(p, v, __ATOMIC_RELAXED, __HIP_MEMORY_SCOPE_AGENT); }
__device__ __forceinline__ unsigned xb_xcc_id() { return (unsigned)__builtin_amdgcn_s_getreg((3 << 11) | 20) & 0xFu; }
#define XB_SPIN(cond, bar) do { unsigned _sp = 0; while (cond) { __builtin_amdgcn_s_sleep(1); \
    if ((++_sp & 255u) == 0u) { if (xb_ld(&(bar)[XB_TMO])) break; if (_sp > XB_SPIN_CAP) { atomicAdd(&(bar)[XB_TMO], 1u); break; } } } } while (0)

struct XcdBarrier {
    unsigned* bar; unsigned x;
    volatile LAS unsigned* st;
};

__device__ __forceinline__ XcdBarrier xcd_barrier_post(unsigned* bar, volatile LAS unsigned* st) {
    XcdBarrier b; b.bar = bar; b.x = xb_xcc_id(); b.st = st;
    if (threadIdx.x == 0) (void)xb_add(&bar[XB_XCNT(b.x)], 1u);
    return b;
}
__device__ __forceinline__ void xcd_barrier_complete(unsigned* bar, unsigned x, unsigned& nloc, unsigned& nx) {
    const unsigned G = gridDim.x * gridDim.y * gridDim.z;
    unsigned sum, cnt, mine, sp = 0u;
    for (;;) {
        sum = 0u; cnt = 0u; mine = 0u;
#pragma unroll
        for (unsigned j = 0; j < 16; ++j) { const unsigned c = xb_ld(&bar[XB_XCNT(j)]); sum += c; cnt += (c > 0u) ? 1u : 0u; mine = (j == x) ? c : mine; }
        if (sum == G) break;
        __builtin_amdgcn_s_sleep(1);
        if ((++sp & 255u) == 0u) { if (xb_ld(&bar[XB_TMO])) break; if (sp > XB_SPIN_CAP) { atomicAdd(&bar[XB_TMO], 1u); break; } }
    }
    nloc = mine > 0u ? mine : 1u; nx = cnt > 0u ? cnt : 1u;
}

__device__ __forceinline__ void xcd_barrier(const XcdBarrier& b) {
    asm volatile("s_waitcnt vmcnt(0)" ::: "memory");
    __syncthreads();
    if (threadIdx.x == 0) {
        unsigned* bar = b.bar;
        __builtin_amdgcn_s_waitcnt(0);
        unsigned nloc = b.st[0], nx = b.st[1];
        if (nloc == 0u) { xcd_barrier_complete(bar, b.x, nloc, nx); b.st[0] = nloc; b.st[1] = nx; }
        const unsigned old = xb_add(&bar[XB_XSUB(b.x)], 1u);
        const unsigned gen = old / nloc;
        if (old + 1u == (gen + 1u) * nloc) {
            __builtin_amdgcn_fence(__ATOMIC_RELEASE, "agent");
            asm volatile("s_waitcnt vmcnt(0)" ::: "memory");
            const unsigned og = xb_add(&bar[XB_TOP], 1u);
            const unsigned tg = og / nx;
            if (og + 1u == (tg + 1u) * nx) xb_add(&bar[XB_TOPGEN], 1u);
            else XB_SPIN(xb_ld(&bar[XB_TOPGEN]) == tg, bar);
            __builtin_amdgcn_fence(__ATOMIC_ACQUIRE, "agent");
            xb_add(&bar[XB_XGEN(b.x)], 1u);
            asm volatile("s_waitcnt vmcnt(0)" ::: "memory");
        } else {
            XB_SPIN(xb_ld(&bar[XB_XGEN(b.x)]) == gen, bar);
            __builtin_amdgcn_fence(__ATOMIC_ACQUIRE, "agent");
            asm volatile("s_waitcnt vmcnt(0)" ::: "memory");
        }
    }
    __syncthreads();
}

__device__ __forceinline__ float bf2f(bf16 b) { return __uint_as_float(((unsigned)b) << 16); }
__device__ __forceinline__ float wave_sum(float v) {
#pragma unroll
    for (int o = 1; o < 64; o <<= 1) v += __shfl_xor(v, o);
    return v;
}
__device__ __forceinline__ float sigmoid_f(float x) { return 1.0f / (1.0f + expf(-x)); }
__device__ __forceinline__ float silu_x(float x) { return x / (1.0f + expf(-x)); }
__device__ __forceinline__ float softplus_f(float x) { return fmaxf(x, 0.0f) + log1pf(expf(-fabsf(x))); }
__device__ __forceinline__ float logsigmoid_f(float x) { return fminf(x, 0.0f) - log1pf(expf(-fabsf(x))); }
__device__ __forceinline__ float gelu_tanh_f(float x) { const float u = 0.7978845608028654f * (x + 0.044715f * x * x * x); return 0.5f * x * (1.0f + tanhf(u)); }

__device__ __forceinline__ void tr_item(const float* W, size_t ldw, int scol0, int nvalid, bf16* WT, int K, int drow0, int k0, LAS float* scr, int lane) {
    const int j = lane & 31;
#pragma unroll 8
    for (int i = 0; i < 32; ++i) { const int kk = 2 * i + (lane >> 5); scr[kk * 33 + j] = (j < nvalid) ? W[(size_t)(k0 + kk) * ldw + scol0 + j] : 0.0f; }
    LDS_WAIT(); asm volatile("" ::: "memory");
    const int c = lane & 7;
#pragma unroll
    for (int jj = 0; jj < 4; ++jj) { const int n = (lane >> 3) + 8 * jj; const LAS float* s = scr + (8 * c) * 33 + n;
        v4u o; o.x = pk2(s[0 * 33], s[1 * 33]); o.y = pk2(s[2 * 33], s[3 * 33]); o.z = pk2(s[4 * 33], s[5 * 33]); o.w = pk2(s[6 * 33], s[7 * 33]);
        *(GAS v4u*)(WT + (size_t)(drow0 + n) * K + k0 + 8 * c) = o; }
    LDS_WAIT(); asm volatile("" ::: "memory");
}
constexpr int IT_EIN = (N_EIN / 32) * (D / 64), IT_EOUT = (D / 32) * (D / 64), IT_F13 = (N_F13 / 32) * (D / 64), IT_F2 = (D / 32) * (FF / 64), IT_OIN = (N_OIN / 32) * (D / 64), IT_OOUT = (D / 32) * (K_OOUT / 64);
constexpr int IT_SMALL = IT_EIN + IT_EOUT + IT_F13 + IT_F2 + IT_OIN + IT_OOUT;
constexpr int IT_E13 = (NE * N_E13 / 32) * (D / 64), IT_E2 = (NE * D / 32) * (FE / 64), IT_EXP = IT_E13 + IT_E2;

__device__ __forceinline__ void cvt_small_item(const float* const* in, unsigned char* ws, int it, LAS float* scr, int lane) {
    int r = it;
    if (r < IT_EIN) { const int db = r / (D / 64), kb = r % (D / 64), r0 = 32 * db;
        if (r0 >= E_GK && r0 < E_XB) return;
        const int sc = r0 < E_GK ? r0 : r0 - 240;
        tr_item(in[1], 2576, sc, 32, (bf16*)(ws + WS_WEIN), D, r0, 64 * kb, scr, lane); return; } r -= IT_EIN;
    if (r < IT_EOUT) { const int db = r / (D / 64), kb = r % (D / 64); tr_item(in[12], D, 32 * db, 32, (bf16*)(ws + WS_WEOUT), D, 32 * db, 64 * kb, scr, lane); return; } r -= IT_EOUT;
    if (r < IT_F13) { const int db = r / (D / 64), kb = r % (D / 64), r0 = 32 * db, tile = r0 >> 8, within = r0 & 255;
        tr_item(within < 128 ? in[15] : in[16], FF, tile * 128 + (within & 127), 32, (bf16*)(ws + WS_WF13), D, r0, 64 * kb, scr, lane); return; } r -= IT_F13;
    if (r < IT_F2) { const int db = r / (FF / 64), kb = r % (FF / 64); tr_item(in[17], D, 32 * db, 32, (bf16*)(ws + WS_WF2), FF, 32 * db, 64 * kb, scr, lane); return; } r -= IT_F2;
    if (r < IT_OIN) { const int db = r / (D / 64), kb = r % (D / 64), r0 = 32 * db;
        int sc, nv; if (r0 < O_R) { sc = r0; nv = 32; } else if (r0 < O_DT) { sc = r0 + 16; nv = 32; } else if (r0 == O_DT) { sc = 2560; nv = 16; } else { sc = 0; nv = 0; }
        tr_item(in[20], 4368, sc, nv, (bf16*)(ws + WS_WOIN), D, r0, 64 * kb, scr, lane); return; } r -= IT_OIN;
    { const int db = r / (K_OOUT / 64), kb = r % (K_OOUT / 64); tr_item(in[38], D, 32 * db, 32, (bf16*)(ws + WS_WOOUT), K_OOUT, 32 * db, 64 * kb, scr, lane); }
}
__device__ __forceinline__ void cvt_exp_item(const float* const* in, unsigned char* ws, int it, LAS float* scr, int lane) {
    int r = it;
    if (r < IT_E13) { const int db = r / (D / 64), kb = r % (D / 64), r0 = 32 * db, e = r0 / N_E13, rr = r0 - e * N_E13, tile = rr >> 8, within = rr & 255;
        const float* W = (within < 128 ? in[42] : in[43]) + (size_t)e * D * FE;
        tr_item(W, FE, tile * 128 + (within & 127), 32, (bf16*)(ws + WS_EXP13), D, r0, 64 * kb, scr, lane); return; } r -= IT_E13;
    { const int db = r / (FE / 64), kb = r % (FE / 64), r0 = 32 * db, e = r0 / D;
        tr_item(in[44] + (size_t)e * FE * D, D, r0 - e * D, 32, (bf16*)(ws + WS_EXP2), FE, r0, 64 * kb, scr, lane); }
}

template <int MODE>
__device__ __forceinline__ void ln_rows(const float* xin, const float* y, const float* gam, const float* bet, float* outf, bf16* outb,
                                        const float* router, unsigned char* ws, gu32* ctl, int gw, int NGW, int lane) {
    for (int m = gw; m < M; m += NGW) {
        const GAS f32x4* xr = (const GAS f32x4*)(xin + (size_t)m * D) + lane;
        f32x4 v[4];
        if (MODE == 2) {
            const int* rdst = (const int*)(ws + WS_ROUTE + RT_DST) + 2 * m; const float* rw = (const float*)(ws + WS_ROUTE + RT_W) + 2 * m;
            const int d0 = rdst[0], d1 = rdst[1]; const float w0 = rw[0], w1 = rw[1];
            const GAS v2u* y0 = (const GAS v2u*)((const bf16*)(ws + WS_XY) + (size_t)d0 * D) + lane; const GAS v2u* y1 = (const GAS v2u*)((const bf16*)(ws + WS_XY) + (size_t)d1 * D) + lane;
#pragma unroll
            for (int j = 0; j < 4; ++j) { const v2u a = y0[64 * j], b = y1[64 * j]; const f32x4 xv = xr[64 * j];
                v[j].x = ALPHA * xv.x + w0 * __uint_as_float(a.x << 16) + w1 * __uint_as_float(b.x << 16);
                v[j].y = ALPHA * xv.y + w0 * __uint_as_float(a.x & 0xffff0000u) + w1 * __uint_as_float(b.x & 0xffff0000u);
                v[j].z = ALPHA * xv.z + w0 * __uint_as_float(a.y << 16) + w1 * __uint_as_float(b.y << 16);
                v[j].w = ALPHA * xv.w + w0 * __uint_as_float(a.y & 0xffff0000u) + w1 * __uint_as_float(b.y & 0xffff0000u); }
        } else {
            const GAS f32x4* yr = (const GAS f32x4*)(y + (size_t)m * D) + lane;
#pragma unroll
            for (int j = 0; j < 4; ++j) { const f32x4 xv = xr[64 * j], yv = yr[64 * j]; v[j] = xv * ALPHA + yv; }
        }
        float s = 0.f;
#pragma unroll
        for (int j = 0; j < 4; ++j) s += (v[j].x + v[j].y) + (v[j].z + v[j].w);
        const float mean = wave_sum(s) * (1.f / D); float s2 = 0.f;
#pragma unroll
        for (int j = 0; j < 4; ++j) { v[j] = v[j] - mean; s2 += (v[j].x * v[j].x + v[j].y * v[j].y) + (v[j].z * v[j].z + v[j].w * v[j].w); }
        const float rstd = 1.f / sqrtf(wave_sum(s2) * (1.f / D) + LN_EPS);
        GAS f32x4* of = (GAS f32x4*)(outf + (size_t)m * D) + lane;
#pragma unroll
        for (int j = 0; j < 4; ++j) { const f32x4 gv = ((const GAS f32x4*)gam)[lane + 64 * j], bv = ((const GAS f32x4*)bet)[lane + 64 * j]; v[j] = v[j] * rstd * gv + bv; of[64 * j] = v[j]; }
        if (MODE != 2) { GAS v2u* ob = (GAS v2u*)(outb + (size_t)m * D) + lane;
#pragma unroll
            for (int j = 0; j < 4; ++j) { v2u o; o.x = pk2(v[j].x, v[j].y); o.y = pk2(v[j].z, v[j].w); ob[64 * j] = o; } }
        if (MODE == 1) {
            float lg[8];
#pragma unroll
            for (int e = 0; e < 8; ++e) lg[e] = 0.f;
#pragma unroll
            for (int j = 0; j < 4; ++j) {
#pragma unroll
                for (int i = 0; i < 4; ++i) { const int c = 4 * lane + 256 * j + i; const f32x4 r0 = ((const GAS f32x4*)router)[2 * c], r1 = ((const GAS f32x4*)router)[2 * c + 1]; const float xv = v[j][i];
                    lg[0] += xv * r0.x; lg[1] += xv * r0.y; lg[2] += xv * r0.z; lg[3] += xv * r0.w; lg[4] += xv * r1.x; lg[5] += xv * r1.y; lg[6] += xv * r1.z; lg[7] += xv * r1.w; } }
#pragma unroll
            for (int e = 0; e < 8; ++e) lg[e] = wave_sum(lg[e]);
            int i0 = 0; float v0 = lg[0];
#pragma unroll
            for (int e = 1; e < 8; ++e) if (lg[e] > v0) { v0 = lg[e]; i0 = e; }
            int i1 = -1; float v1 = -INFINITY;
#pragma unroll
            for (int e = 0; e < 8; ++e) if (e != i0 && lg[e] > v1) { v1 = lg[e]; i1 = e; }
            const float w0 = 1.0f / (1.0f + expf(v1 - v0)), w1 = 1.0f - w0;
            if (lane == 0) {
                const unsigned p0 = __hip_atomic_fetch_add(ctl + CW_CNT + 64 * i0, 1u, RLX_AGENT), p1 = __hip_atomic_fetch_add(ctl + CW_CNT + 64 * i1, 1u, RLX_AGENT);
                int* re = (int*)(ws + WS_ROUTE + RT_E) + 2 * m; int* rp = (int*)(ws + WS_ROUTE + RT_P) + 2 * m; float* rw = (float*)(ws + WS_ROUTE + RT_W) + 2 * m;
                re[0] = i0; re[1] = i1; rp[0] = (int)p0; rp[1] = (int)p1; rw[0] = w0; rw[1] = w1; }
        }
    }
}

__device__ __forceinline__ void gla_item(const float* const* in, unsigned char* ws, LAS float* L, int item, int tid) {
    const int b = item >> 2, h = item & 3, lane = tid & 63, wave = tid >> 6;
    const bf16* P = (const bf16*)(ws + WS_P); bf16* mix = (bf16*)(ws + WS_MIX0);
    const float* gk_b = in[3]; const float* gnorm = in[4];
    constexpr int TB = 32;
    LAS float* qs = L; LAS float* ks = qs + TB * 64; LAS float* eg = ks + TB * 64; LAS float* vs = eg + TB * 64; LAS float* gs = vs + TB * 128; LAS float* ob = gs + TB * 128;
    const int v = tid >> 2, kq = tid & 3;
    float S[16];
#pragma unroll
    for (int j = 0; j < 16; ++j) S[j] = 0.f;
    for (int t0 = 0; t0 < T; t0 += TB) {
        for (int idx = tid; idx < TB * 64; idx += 512) { const int t = idx >> 6, d = idx & 63; const bf16* pr = P + (size_t)(b * T + t0 + t) * N_EIN;
            qs[idx] = bf2f(pr[E_Q + h * 64 + d]) * 0.125f; ks[idx] = bf2f(pr[E_K + h * 64 + d]);
            const float pre = bf2f(pr[E_GK + h * 64 + d]) + gk_b[h * 64 + d]; eg[idx] = expf(logsigmoid_f(pre) * (1.0f / 16.0f)); }
        for (int idx = tid; idx < TB * 128; idx += 512) { const int t = idx >> 7, c = idx & 127; const bf16* pr = P + (size_t)(b * T + t0 + t) * N_EIN;
            vs[idx] = bf2f(pr[E_V + h * 128 + c]); gs[idx] = bf2f(pr[E_G + h * 128 + c]); }
        __syncthreads();
#pragma unroll 2
        for (int t = 0; t < TB; ++t) {
            const float vv = vs[t * 128 + v]; float acc = 0.f;
#pragma unroll
            for (int j = 0; j < 16; ++j) { const int d = 16 * kq + j; S[j] = S[j] * eg[t * 64 + d] + ks[t * 64 + d] * vv; acc += qs[t * 64 + d] * S[j]; }
            acc += __shfl_xor(acc, 1); acc += __shfl_xor(acc, 2);
            if (kq == 0) ob[t * 128 + v] = acc;
        }
        __syncthreads();
        for (int i = 0; i < 4; ++i) { const int t = wave * 4 + i; const float o0 = ob[t * 128 + lane], o1 = ob[t * 128 + 64 + lane];
            const float rs = 1.0f / sqrtf(wave_sum(o0 * o0 + o1 * o1) * (1.0f / 128.0f) + 1e-5f);
            bf16* mr = mix + (size_t)(b * T + t0 + t) * D + h * 128;
            mr[lane] = (bf16)f2bf(o0 * rs * gnorm[lane] * silu_x(gs[t * 128 + lane])); mr[64 + lane] = (bf16)f2bf(o1 * rs * gnorm[64 + lane] * silu_x(gs[t * 128 + 64 + lane])); }
        __syncthreads();
    }
}
__device__ __forceinline__ void lru_item(const float* const* in, unsigned char* ws, LAS float* L, int item, int tid) {
    const int b = item >> 3, n = item & 7;
    const bf16* P = (const bf16*)(ws + WS_P); bf16* mix = (bf16*)(ws + WS_MIX0);
    const float* conv_w = in[5]; const float* conv_b = in[6]; const float* wa = in[7] + n * 4096; const float* ba = in[8]; const float* wx = in[9] + n * 4096; const float* bx = in[10]; const float* lam = in[11];
    LAS float* xbw = L; LAS float* xc = xbw + 67 * 64; LAS float* was = xc + 4096; LAS float* wxs = was + 4096; LAS float* aa = wxs + 4096; LAS float* uu = aa + 4096;
    for (int idx = tid; idx < 4096; idx += 512) { was[idx] = wa[idx]; wxs[idx] = wx[idx]; }
    const int c = tid & 63, tq = tid >> 6, ch = n * 64 + c;
    const float cw0 = conv_w[ch], cw1 = conv_w[512 + ch], cw2 = conv_w[1024 + ch], cw3 = conv_w[1536 + ch], cb = conv_b[ch];
    const float bac = ba[ch], bxc = bx[ch], spl = softplus_f(-lam[ch]);
    float hcarry = 0.f;
    for (int t0 = 0; t0 < T; t0 += 64) {
        for (int idx = tid; idx < 67 * 64; idx += 512) { const int r = idx >> 6, cc = idx & 63, tt = t0 - 3 + r;
            xbw[idx] = tt >= 0 ? bf2f(P[(size_t)(b * T + tt) * N_EIN + E_XB + n * 64 + cc]) : 0.f; }
        __syncthreads();
        for (int i = 0; i < 8; ++i) { const int t = tq * 8 + i; xc[t * 64 + c] = cb + cw0 * xbw[t * 64 + c] + cw1 * xbw[(t + 1) * 64 + c] + cw2 * xbw[(t + 2) * 64 + c] + cw3 * xbw[(t + 3) * 64 + c]; }
        __syncthreads();
#pragma unroll 1
        for (int i = 0; i < 8; ++i) { const int t = tq * 8 + i; float sr = bac, si = bxc;
#pragma unroll 8
            for (int k = 0; k < 64; ++k) { const float xv = xc[t * 64 + k]; sr += xv * was[k * 64 + c]; si += xv * wxs[k * 64 + c]; }
            const float r = sigmoid_f(sr), ig = sigmoid_f(si), log_a = -8.0f * r * spl;
            aa[t * 64 + c] = expf(log_a); uu[t * 64 + c] = sqrtf(-expm1f(2.0f * log_a)) * (ig * xc[t * 64 + c]); }
        __syncthreads();
        if (tid < 64) { float hh = hcarry;
#pragma unroll 4
            for (int t = 0; t < 64; ++t) { hh = aa[t * 64 + c] * hh + uu[t * 64 + c]; uu[t * 64 + c] = hh; } hcarry = hh; }
        __syncthreads();
        for (int i = 0; i < 8; ++i) { const int t = tq * 8 + i; const size_t m = (size_t)(b * T + t0 + t);
            const float gt = bf2f(P[m * N_EIN + E_GATE + ch]); mix[m * D + 512 + ch] = (bf16)f2bf(uu[t * 64 + c] * gelu_tanh_f(gt)); }
        __syncthreads();
    }
}

__device__ __forceinline__ void ssd_item(const float* const* in, unsigned char* ws, LAS float* L, int item, int tid) {
    const int b = item >> 4, h = item & 15, g = h >> 3;
    const bf16* P = (const bf16*)(ws + WS_P); float* ssdy = (float*)(ws + WS_SSDY);
    const float* conv_w = in[21]; const float* conv_b = in[22];
    const float dtb = in[23][h], a_h = -expf(in[24][h]), dsk = in[25][h];
    constexpr int TB = 32;
    LAS float* raw = L; LAS float* xs = raw + (TB + 3) * 320; LAS float* Bs = xs + TB * 64; LAS float* Cs = Bs + TB * 128; LAS float* dts = Cs + TB * 128; LAS float* das = dts + TB;
    const int p = tid >> 3, sq = tid & 7;
    float st[16];
#pragma unroll
    for (int j = 0; j < 16; ++j) st[j] = 0.f;
    for (int t0 = 0; t0 < T; t0 += TB) {
        for (int idx = tid; idx < (TB + 3) * 320; idx += 512) { const int r = idx / 320, j = idx - r * 320, tt = t0 - 3 + r;
            const int col = j < 64 ? O_XS + h * 64 + j : (j < 192 ? O_B + g * 128 + (j - 64) : O_C + g * 128 + (j - 192));
            raw[idx] = tt >= 0 ? bf2f(P[(size_t)(b * T + tt) * N_OIN + col]) : 0.f; }
        if (tid < TB) { const float dt = softplus_f(bf2f(P[(size_t)(b * T + t0 + tid) * N_OIN + O_DT + h]) + dtb); dts[tid] = dt; das[tid] = expf(dt * a_h); }
        __syncthreads();
        for (int idx = tid; idx < TB * 320; idx += 512) { const int t = idx / 320, j = idx - t * 320;
            const int ch = j < 64 ? h * 64 + j : (j < 192 ? 1024 + g * 128 + (j - 64) : 1280 + g * 128 + (j - 192));
            const float cv = conv_b[ch] + conv_w[ch] * raw[t * 320 + j] + conv_w[1536 + ch] * raw[(t + 1) * 320 + j] + conv_w[3072 + ch] * raw[(t + 2) * 320 + j] + conv_w[4608 + ch] * raw[(t + 3) * 320 + j];
            const float sv = silu_x(cv);
            if (j < 64) xs[t * 64 + j] = sv; else if (j < 192) Bs[t * 128 + (j - 64)] = sv; else Cs[t * 128 + (j - 192)] = sv; }
        __syncthreads();
#pragma unroll 2
        for (int t = 0; t < TB; ++t) {
            const float xv = xs[t * 64 + p], xdt = xv * dts[t], dA = das[t]; float acc = 0.f;
#pragma unroll
            for (int j = 0; j < 16; ++j) { const int s = 16 * sq + j; st[j] = st[j] * dA + xdt * Bs[t * 128 + s]; acc += Cs[t * 128 + s] * st[j]; }
            acc += __shfl_xor(acc, 1); acc += __shfl_xor(acc, 2); acc += __shfl_xor(acc, 4);
            if (sq == 0) ssdy[(size_t)(b * T + t0 + t) * D + h * 64 + p] = acc + dsk * xv;
        }
        __syncthreads();
    }
}
__device__ __forceinline__ void ssd_norm_rows(const float* const* in, unsigned char* ws, int gw, int NGW, int lane) {
    const bf16* P = (const bf16*)(ws + WS_P); const float* ssdy = (const float*)(ws + WS_SSDY); bf16* mix = (bf16*)(ws + WS_MIX1); const float* nw = in[26];
    for (int m = gw; m < M; m += NGW) {
        float yv[16]; float ss = 0.f;
#pragma unroll
        for (int q = 0; q < 4; ++q) { const f32x4 y4 = *(const GAS f32x4*)(ssdy + (size_t)m * D + 16 * lane + 4 * q); const v2u z2 = *(const GAS v2u*)(P + (size_t)m * N_OIN + O_Z + 16 * lane + 4 * q);
            const float z0 = __uint_as_float(z2.x << 16), z1 = __uint_as_float(z2.x & 0xffff0000u), z2f = __uint_as_float(z2.y << 16), z3 = __uint_as_float(z2.y & 0xffff0000u);
            yv[4 * q] = y4.x * silu_x(z0); yv[4 * q + 1] = y4.y * silu_x(z1); yv[4 * q + 2] = y4.z * silu_x(z2f); yv[4 * q + 3] = y4.w * silu_x(z3); }
#pragma unroll
        for (int i = 0; i < 16; ++i) ss += yv[i] * yv[i];
#pragma unroll
        for (int o = 1; o < 32; o <<= 1) ss += __shfl_xor(ss, o);
        const float rs = 1.0f / sqrtf(ss * (1.0f / 512.0f) + 1e-5f);
        v4u o0, o1;
        o0.x = pk2(yv[0] * rs * nw[16 * lane + 0], yv[1] * rs * nw[16 * lane + 1]); o0.y = pk2(yv[2] * rs * nw[16 * lane + 2], yv[3] * rs * nw[16 * lane + 3]);
        o0.z = pk2(yv[4] * rs * nw[16 * lane + 4], yv[5] * rs * nw[16 * lane + 5]); o0.w = pk2(yv[6] * rs * nw[16 * lane + 6], yv[7] * rs * nw[16 * lane + 7]);
        o1.x = pk2(yv[8] * rs * nw[16 * lane + 8], yv[9] * rs * nw[16 * lane + 9]); o1.y = pk2(yv[10] * rs * nw[16 * lane + 10], yv[11] * rs * nw[16 * lane + 11]);
        o1.z = pk2(yv[12] * rs * nw[16 * lane + 12], yv[13] * rs * nw[16 * lane + 13]); o1.w = pk2(yv[14] * rs * nw[16 * lane + 14], yv[15] * rs * nw[16 * lane + 15]);
        GAS v4u* mo = (GAS v4u*)(mix + (size_t)m * K_OOUT + 16 * lane); mo[0] = o0; mo[1] = o1;
    }
}
__device__ __forceinline__ void rwkv_pre_tile(const float* const* in, unsigned char* ws, LAS float* L, int tile, int tid) {
    const bf16* P = (const bf16*)(ws + WS_P); const float* mu = in[27];
    float* DEC = (float*)(ws + WS_DEC); float* AA = (float*)(ws + WS_AA); float* GG = (float*)(ws + WS_GG);
    LAS float* tw = L; LAS float* xa = tw + 32 * 64; LAS float* sg = xa + 32 * 64;
    const int m0 = tile * 32;
    for (int idx = tid; idx < 32 * 256; idx += 512) { const int t = idx >> 8, c = idx & 255, m = m0 + t;
        const float cur = bf2f(P[(size_t)m * N_OIN + O_R + 1536 + c]); const float prev = (m % T) ? bf2f(P[(size_t)(m - 1) * N_OIN + O_R + 1536 + c]) : 0.f;
        const float pm = cur + (prev - cur) * mu[1536 + c];
        if (c < 64) tw[t * 64 + c] = tanhf(pm); else if (c < 128) xa[t * 64 + (c - 64)] = pm; else sg[t * 128 + (c - 128)] = sigmoid_f(pm); }
    __syncthreads();
    const int j = tid; float acc[32];
#pragma unroll
    for (int t = 0; t < 32; ++t) acc[t] = 0.f;
    for (int i = 0; i < 64; i += 4) { const float w0 = in[29][(i) * 512 + j], w1 = in[29][(i + 1) * 512 + j], w2 = in[29][(i + 2) * 512 + j], w3 = in[29][(i + 3) * 512 + j];
#pragma unroll
        for (int t = 0; t < 32; ++t) { const f32x4 x = *(const LAS f32x4*)(tw + t * 64 + i); acc[t] += x.x * w0 + x.y * w1 + x.z * w2 + x.w * w3; } }
    { const float w0j = in[28][j];
#pragma unroll
      for (int t = 0; t < 32; ++t) { const float wl = -softplus_f(-(w0j + acc[t])) - 0.5f; DEC[(size_t)(m0 + t) * 512 + j] = expf(-expf(wl)); } }
#pragma unroll
    for (int t = 0; t < 32; ++t) acc[t] = 0.f;
    for (int i = 0; i < 64; i += 4) { const float w0 = in[31][(i) * 512 + j], w1 = in[31][(i + 1) * 512 + j], w2 = in[31][(i + 2) * 512 + j], w3 = in[31][(i + 3) * 512 + j];
#pragma unroll
        for (int t = 0; t < 32; ++t) { const f32x4 x = *(const LAS f32x4*)(xa + t * 64 + i); acc[t] += x.x * w0 + x.y * w1 + x.z * w2 + x.w * w3; } }
    { const float a0j = in[30][j];
#pragma unroll
      for (int t = 0; t < 32; ++t) AA[(size_t)(m0 + t) * 512 + j] = sigmoid_f(a0j + acc[t]); }
#pragma unroll
    for (int t = 0; t < 32; ++t) acc[t] = 0.f;
    for (int i = 0; i < 128; i += 4) { const float w0 = in[32][(i) * 512 + j], w1 = in[32][(i + 1) * 512 + j], w2 = in[32][(i + 2) * 512 + j], w3 = in[32][(i + 3) * 512 + j];
#pragma unroll
        for (int t = 0; t < 32; ++t) { const f32x4 x = *(const LAS f32x4*)(sg + t * 128 + i); acc[t] += x.x * w0 + x.y * w1 + x.z * w2 + x.w * w3; } }
#pragma unroll
    for (int t = 0; t < 32; ++t) GG[(size_t)(m0 + t) * 512 + j] = acc[t];
    __syncthreads();
}
__device__ __forceinline__ void rwkv_item(const float* const* in, unsigned char* ws, LAS float* L, int item, int tid) {
    const int b = item >> 3, h = item & 7, lane = tid & 63, wave = tid >> 6;
    const bf16* P = (const bf16*)(ws + WS_P); const float* mu = in[27]; bf16* mix = (bf16*)(ws + WS_MIX1);
    const float* DEC = (const float*)(ws + WS_DEC); const float* AA = (const float*)(ws + WS_AA); const float* GG = (const float*)(ws + WS_GG);
    constexpr int TB = 32;
    LAS float* rs = L; LAS float* wsd = rs + TB * 64; LAS float* k2s = wsd + TB * 64; LAS float* vs = k2s + TB * 64; LAS float* avs = vs + TB * 64; LAS float* bvs = avs + TB * 64; LAS float* yb = bvs + TB * 64; LAS float* bsum = yb + TB * 64;
    const int hc = h * 64 + lane;
    const float mu_r = mu[hc], mu_k = mu[512 + hc], mu_v = mu[1024 + hc], kk_c = in[33][hc], ka_c = in[34][hc], rk_c = in[35][hc], lng = in[36][hc], lnb = in[37][hc];
    const int i = tid >> 3, kq = tid & 7;
    float S[8];
#pragma unroll
    for (int j = 0; j < 8; ++j) S[j] = 0.f;
    for (int t0 = 0; t0 < T; t0 += TB) {
        for (int q = 0; q < 4; ++q) { const int t = wave * 4 + q; const size_t m = (size_t)(b * T + t0 + t); const bf16* pr = P + m * N_OIN + O_R + hc;
            const bool has_prev = (t0 + t) > 0; const bf16* pp = pr - N_OIN;
            const float rc = bf2f(pr[0]), kc = bf2f(pr[512]), vc = bf2f(pr[1024]);
            const float rp = has_prev ? bf2f(pp[0]) : 0.f, kp = has_prev ? bf2f(pp[512]) : 0.f, vp = has_prev ? bf2f(pp[1024]) : 0.f;
            const float r_ = rc + (rp - rc) * mu_r, k_ = kc + (kp - kc) * mu_k, v_ = vc + (vp - vc) * mu_v;
            const float a_ = AA[m * 512 + hc], d_ = DEC[m * 512 + hc];
            const float kkr = k_ * kk_c; const float nrm = sqrtf(wave_sum(kkr * kkr)); const float kk = kkr / fmaxf(nrm, 1e-12f);
            const float k2 = k_ * (1.0f + (a_ - 1.0f) * ka_c);
            rs[t * 64 + lane] = r_; wsd[t * 64 + lane] = d_; k2s[t * 64 + lane] = k2; vs[t * 64 + lane] = v_; avs[t * 64 + lane] = -kk; bvs[t * 64 + lane] = kk * a_;
            const float bs = wave_sum(r_ * k2 * rk_c); if (lane == 0) bsum[t] = bs; }
        __syncthreads();
#pragma unroll 2
        for (int t = 0; t < TB; ++t) {
            float sa = 0.f;
#pragma unroll
            for (int j = 0; j < 8; ++j) sa += S[j] * avs[t * 64 + 8 * kq + j];
            sa += __shfl_xor(sa, 1); sa += __shfl_xor(sa, 2); sa += __shfl_xor(sa, 4);
            const float vv = vs[t * 64 + i]; float y = 0.f;
#pragma unroll
            for (int j = 0; j < 8; ++j) { const int c = t * 64 + 8 * kq + j; S[j] = S[j] * wsd[c] + sa * bvs[c] + vv * k2s[c]; y += S[j] * rs[c]; }
            y += __shfl_xor(y, 1); y += __shfl_xor(y, 2); y += __shfl_xor(y, 4);
            if (kq == 0) yb[t * 64 + i] = y;
        }
        __syncthreads();
        for (int q = 0; q < 4; ++q) { const int t = wave * 4 + q; const size_t m = (size_t)(b * T + t0 + t);
            const float y = yb[t * 64 + lane]; const float mean = wave_sum(y) * (1.0f / 64.0f); const float dv = y - mean; const float var = wave_sum(dv * dv) * (1.0f / 64.0f);
            const float yn = dv * (1.0f / sqrtf(var + 64e-5f)) * lng + lnb;
            mix[m * K_OOUT + 1024 + hc] = (bf16)f2bf((yn + bsum[t] * vs[t * 64 + lane]) * GG[m * 512 + hc]); }
        __syncthreads();
    }
}

typedef short bf16x8_t __attribute__((ext_vector_type(8)));
typedef float f32x16 __attribute__((ext_vector_type(16)));
template <int K>
__device__ __forceinline__ void mm32(f32x16& acc, const LAS bf16* A, int pa, int arow0, const LAS bf16* Bt, int pb, int brow0, int lane) {
    const LAS bf16* ap = A + (arow0 + (lane & 31)) * pa + 8 * (lane >> 5); const LAS bf16* bp = Bt + (brow0 + (lane & 31)) * pb + 8 * (lane >> 5);
#pragma unroll
    for (int ks = 0; ks < K / 16; ++ks) { const bf16x8_t a = *(const LAS bf16x8_t*)(ap + 16 * ks); const bf16x8_t b = *(const LAS bf16x8_t*)(bp + 16 * ks);
        acc = __builtin_amdgcn_mfma_f32_32x32x16_bf16(a, b, acc, 0, 0, 0); }
}
__device__ __forceinline__ int accrow(int r, int lane) { return (r & 3) + 8 * (r >> 2) + 4 * (lane >> 5); }

namespace gl {
constexpr int PQ = 72, POB = 132;
constexpr int L_RQ = 0, L_RK = 8192, L_RGK = 16384, L_RV = 24576, L_OB = 0, L_RG = 40960;
constexpr int L_QT = 57344, L_KT = L_QT + 9216, L_KD = L_KT + 9216, L_VT = L_KD + 9216, L_AT = L_VT + 18432, L_ST = L_AT + 9216, L_SEG = L_ST + 18432, L_DEC = L_SEG + 2048, L_END = L_DEC + 256;
}
__device__ __forceinline__ void gla_chunk_item(const float* const* in, unsigned char* ws, LAS unsigned char* lds, int item, int tid) {
    using namespace gl;
    const int b = item >> 2, h = item & 3, lane = tid & 63, wave = tid >> 6;
    const bf16* P = (const bf16*)(ws + WS_P); bf16* mix = (bf16*)(ws + WS_MIX0);
    const float* gnorm = in[4];
    LAS bf16* RQ = (LAS bf16*)(lds + L_RQ); LAS bf16* RK = (LAS bf16*)(lds + L_RK); LAS bf16* RGK = (LAS bf16*)(lds + L_RGK); LAS bf16* RV = (LAS bf16*)(lds + L_RV); LAS bf16* RG = (LAS bf16*)(lds + L_RG);
    LAS float* OB = (LAS float*)(lds + L_OB);
    LAS bf16* QT = (LAS bf16*)(lds + L_QT); LAS bf16* KT = (LAS bf16*)(lds + L_KT); LAS bf16* KD = (LAS bf16*)(lds + L_KD); LAS bf16* VT = (LAS bf16*)(lds + L_VT); LAS bf16* AT = (LAS bf16*)(lds + L_AT); LAS bf16* ST = (LAS bf16*)(lds + L_ST);
    LAS float* SEG = (LAS float*)(lds + L_SEG); LAS float* DEC = (LAS float*)(lds + L_DEC);
    const int lt = tid >> 3, lc = tid & 7;
    const size_t rowbase = (size_t)b * T;
    v4u rq, rk, rgk, rv0, rv1, rg0, rg1;
#define GLA_LOAD(t0_) do { const bf16* pr = P + (rowbase + (t0_) + lt) * N_EIN + h * 64 + 8 * lc; rq = *(const GAS v4u*)(pr + E_Q); rk = *(const GAS v4u*)(pr + E_K); rgk = *(const GAS v4u*)(pr + E_GK); \
        const bf16* p0 = P + (rowbase + (t0_) + (tid >> 4)) * N_EIN + h * 128 + 8 * (tid & 15); const bf16* p1 = p0 + (size_t)32 * N_EIN; \
        rv0 = *(const GAS v4u*)(p0 + E_V); rv1 = *(const GAS v4u*)(p1 + E_V); rg0 = *(const GAS v4u*)(p0 + E_G); rg1 = *(const GAS v4u*)(p1 + E_G); } while (0)
    for (int i = tid; i < 128 * PQ / 2; i += 512) ((LAS unsigned*)ST)[i] = 0u;
    f32x16 S;
#pragma unroll
    for (int r = 0; r < 16; ++r) S[r] = 0.f;
    const int db = wave >> 2, vb = wave & 3, tb = wave >> 2;
    const int ed = tid & 63, eseg = tid >> 6;
    const float gkb = in[3][h * 64 + ed];
    const int ev = tid & 127, evs = tid >> 7;
    GLA_LOAD(0);
    for (int c = 0; c < T / 64; ++c) {
        const int t0 = c * 64;
        *(LAS v4u*)(RQ + lt * 64 + 8 * lc) = rq; *(LAS v4u*)(RK + lt * 64 + 8 * lc) = rk; *(LAS v4u*)(RGK + lt * 64 + 8 * lc) = rgk;
        *(LAS v4u*)(RV + (tid >> 4) * 128 + 8 * (tid & 15)) = rv0; *(LAS v4u*)(RV + (32 + (tid >> 4)) * 128 + 8 * (tid & 15)) = rv1;
        *(LAS v4u*)(RG + (tid >> 4) * 128 + 8 * (tid & 15)) = rg0; *(LAS v4u*)(RG + (32 + (tid >> 4)) * 128 + 8 * (tid & 15)) = rg1;
        __syncthreads();
        if (c + 1 < T / 64) GLA_LOAD(t0 + 64);
        float cs[8];
        { float run = 0.f;
#pragma unroll
          for (int i = 0; i < 8; ++i) { const float gkv = bf2f(RGK[(8 * eseg + i) * 64 + ed]) + gkb; run += logsigmoid_f(gkv) * (1.0f / 16.0f); cs[i] = run; }
          SEG[eseg * 64 + ed] = run; }
        __syncthreads();
        { float prefix = 0.f, total = 0.f;
#pragma unroll
          for (int s = 0; s < 8; ++s) { const float v = SEG[s * 64 + ed]; total += v; prefix += (s < eseg) ? v : 0.f; }
          unsigned kd[4];
#pragma unroll
          for (int i = 0; i < 8; i += 2) { const int ta = 8 * eseg + i; const float b0 = prefix + cs[i], b1 = prefix + cs[i + 1];
              const float q0 = bf2f(RQ[ta * 64 + ed]), q1 = bf2f(RQ[(ta + 1) * 64 + ed]), k0 = bf2f(RK[ta * 64 + ed]), k1 = bf2f(RK[(ta + 1) * 64 + ed]);
              QT[ta * PQ + ed] = (bf16)f2bf(q0 * 0.125f * expf(b0)); QT[(ta + 1) * PQ + ed] = (bf16)f2bf(q1 * 0.125f * expf(b1));
              KT[ta * PQ + ed] = (bf16)f2bf(k0 * expf(-b0)); KT[(ta + 1) * PQ + ed] = (bf16)f2bf(k1 * expf(-b1));
              kd[i >> 1] = pk2(k0 * expf(total - b0), k1 * expf(total - b1)); }
          *(LAS v4u*)(KD + ed * PQ + 8 * eseg) = (v4u){kd[0], kd[1], kd[2], kd[3]};
          if (eseg == 0) DEC[ed] = expf(total);
          unsigned vv[8];
#pragma unroll
          for (int i = 0; i < 16; i += 2) vv[i >> 1] = (unsigned)RV[(16 * evs + i) * 128 + ev] | ((unsigned)RV[(16 * evs + i + 1) * 128 + ev] << 16);
          *(LAS v4u*)(VT + ev * PQ + 16 * evs) = (v4u){vv[0], vv[1], vv[2], vv[3]}; *(LAS v4u*)(VT + ev * PQ + 16 * evs + 8) = (v4u){vv[4], vv[5], vv[6], vv[7]}; }
        __syncthreads();
        f32x16 o;
#pragma unroll
        for (int r = 0; r < 16; ++r) o[r] = 0.f;
        mm32<64>(o, QT, PQ, 32 * tb, ST, PQ, 32 * vb, lane);
        if (wave < 4) { const int tb2 = wave >> 1, sb = wave & 1; f32x16 a;
#pragma unroll
            for (int r = 0; r < 16; ++r) a[r] = 0.f;
            if (sb <= tb2) mm32<64>(a, QT, PQ, 32 * tb2, KT, PQ, 32 * sb, lane);
#pragma unroll
            for (int r = 0; r < 16; ++r) { const int tt = 32 * tb2 + accrow(r, lane), ss = 32 * sb + (lane & 31); AT[tt * PQ + ss] = (bf16)f2bf(ss <= tt ? a[r] : 0.f); } }
        __syncthreads();
        mm32<64>(o, AT, PQ, 32 * tb, VT, PQ, 32 * vb, lane);
#pragma unroll
        for (int g4 = 0; g4 < 4; ++g4) { const f32x4 dv = *(const LAS f32x4*)(DEC + 32 * db + 8 * g4 + 4 * (lane >> 5));
            S[4 * g4] *= dv.x; S[4 * g4 + 1] *= dv.y; S[4 * g4 + 2] *= dv.z; S[4 * g4 + 3] *= dv.w; }
        mm32<64>(S, KD, PQ, 32 * db, VT, PQ, 32 * vb, lane);
#pragma unroll
        for (int r = 0; r < 16; ++r) OB[(32 * tb + accrow(r, lane)) * POB + 32 * vb + (lane & 31)] = o[r];
#pragma unroll
        for (int g4 = 0; g4 < 4; ++g4) { v2u w; w.x = pk2(S[4 * g4], S[4 * g4 + 1]); w.y = pk2(S[4 * g4 + 2], S[4 * g4 + 3]);
            *(LAS v2u*)(ST + (32 * vb + (lane & 31)) * PQ + 32 * db + 8 * g4 + 4 * (lane >> 5)) = w; }
        __syncthreads();
        { const int t = tid >> 3, vs = tid & 7; float ov[16]; float ss = 0.f;
#pragma unroll
          for (int q = 0; q < 4; ++q) { const f32x4 x = *(const LAS f32x4*)(OB + t * POB + 16 * vs + 4 * q); ov[4 * q] = x.x; ov[4 * q + 1] = x.y; ov[4 * q + 2] = x.z; ov[4 * q + 3] = x.w; ss += (x.x * x.x + x.y * x.y) + (x.z * x.z + x.w * x.w); }
          ss += __shfl_xor(ss, 1); ss += __shfl_xor(ss, 2); ss += __shfl_xor(ss, 4);
          const float rs = 1.0f / sqrtf(ss * (1.0f / 128.0f) + 1e-5f);
          unsigned ow[8];
#pragma unroll
          for (int i = 0; i < 16; i += 2) { const float g0 = bf2f(RG[t * 128 + 16 * vs + i]), g1 = bf2f(RG[t * 128 + 16 * vs + i + 1]);
              ow[i >> 1] = pk2(ov[i] * rs * gnorm[16 * vs + i] * silu_x(g0), ov[i + 1] * rs * gnorm[16 * vs + i + 1] * silu_x(g1)); }
          GAS v4u* mo = (GAS v4u*)(mix + (rowbase + t0 + t) * D + h * 128 + 16 * vs); mo[0] = (v4u){ow[0], ow[1], ow[2], ow[3]}; mo[1] = (v4u){ow[4], ow[5], ow[6], ow[7]}; }
        __syncthreads();
    }
#undef GLA_LOAD
}
namespace lr {
constexpr int PQ = 72;
constexpr int L_XBW = 0, L_XC = L_XBW + 67 * 64 * 4, L_XCB = L_XC + 16384, L_WA = L_XCB + 9216, L_WX = L_WA + 9216, L_PR = L_WX + 9216, L_AA = L_PR + 32768, L_UU = L_AA + 16384, L_END = L_UU + 16384;
}
__device__ __forceinline__ void lru_chunk_item(const float* const* in, unsigned char* ws, LAS unsigned char* lds, int item, int tid) {
    using namespace lr;
    const int b = item >> 3, n = item & 7, lane = tid & 63, wave = tid >> 6;
    const bf16* P = (const bf16*)(ws + WS_P); bf16* mix = (bf16*)(ws + WS_MIX0);
    const float* conv_w = in[5]; const float* conv_b = in[6]; const float* wa = in[7] + n * 4096; const float* ba = in[8]; const float* wx = in[9] + n * 4096; const float* bx = in[10]; const float* lam = in[11];
    LAS float* xbw = (LAS float*)(lds + L_XBW); LAS float* xc = (LAS float*)(lds + L_XC); LAS bf16* XCB = (LAS bf16*)(lds + L_XCB); LAS bf16* WA = (LAS bf16*)(lds + L_WA); LAS bf16* WX = (LAS bf16*)(lds + L_WX);
    LAS float* PR = (LAS float*)(lds + L_PR); LAS float* aa = (LAS float*)(lds + L_AA); LAS float* uu = (LAS float*)(lds + L_UU);
    for (int idx = tid; idx < 4096; idx += 512) { const int k = idx >> 6, cc = idx & 63; WA[cc * PQ + k] = (bf16)f2bf(wa[idx]); WX[cc * PQ + k] = (bf16)f2bf(wx[idx]); }
    const int c = tid & 63, tq = tid >> 6, ch = n * 64 + c;
    const float cw0 = conv_w[ch], cw1 = conv_w[512 + ch], cw2 = conv_w[1024 + ch], cw3 = conv_w[1536 + ch], cb = conv_b[ch];
    const float bac = ba[ch], bxc = bx[ch], spl = softplus_f(-lam[ch]);
    const int mat = wave >> 2, tb = (wave >> 1) & 1, cbk = wave & 1;
    float hcarry = 0.f;
    for (int t0 = 0; t0 < T; t0 += 64) {
        for (int idx = tid; idx < 67 * 64; idx += 512) { const int r = idx >> 6, cc = idx & 63, tt = t0 - 3 + r;
            xbw[idx] = tt >= 0 ? bf2f(P[(size_t)(b * T + tt) * N_EIN + E_XB + n * 64 + cc]) : 0.f; }
        __syncthreads();
#pragma unroll
        for (int i = 0; i < 8; ++i) { const int t = tq * 8 + i; const float v = cb + cw0 * xbw[t * 64 + c] + cw1 * xbw[(t + 1) * 64 + c] + cw2 * xbw[(t + 2) * 64 + c] + cw3 * xbw[(t + 3) * 64 + c];
            xc[t * 64 + c] = v; XCB[t * PQ + c] = (bf16)f2bf(v); }
        __syncthreads();
        { f32x16 acc;
#pragma unroll
          for (int r = 0; r < 16; ++r) acc[r] = 0.f;
          mm32<64>(acc, XCB, PQ, 32 * tb, mat ? WX : WA, PQ, 32 * cbk, lane);
#pragma unroll
          for (int r = 0; r < 16; ++r) PR[mat * 4096 + (32 * tb + accrow(r, lane)) * 64 + 32 * cbk + (lane & 31)] = acc[r]; }
        __syncthreads();
#pragma unroll
        for (int i = 0; i < 8; ++i) { const int t = tq * 8 + i; const float r = sigmoid_f(PR[t * 64 + c] + bac), ig = sigmoid_f(PR[4096 + t * 64 + c] + bxc), log_a = -8.0f * r * spl;
            aa[t * 64 + c] = expf(log_a); uu[t * 64 + c] = sqrtf(-expm1f(2.0f * log_a)) * (ig * xc[t * 64 + c]); }
        __syncthreads();
        if (tid < 64) { float hh = hcarry;
#pragma unroll 8
            for (int t = 0; t < 64; ++t) { hh = aa[t * 64 + c] * hh + uu[t * 64 + c]; uu[t * 64 + c] = hh; } hcarry = hh; }
        __syncthreads();
#pragma unroll
        for (int i = 0; i < 8; ++i) { const int t = tq * 8 + i; const size_t m = (size_t)(b * T + t0 + t);
            const float gt = bf2f(P[m * N_EIN + E_GATE + ch]); mix[m * D + 512 + ch] = (bf16)f2bf(uu[t * 64 + c] * gelu_tanh_f(gt)); }
        __syncthreads();
    }
}

namespace sd {
constexpr int PQ = 72, PS = 136, RAWP = 320;
constexpr int L_RAW = 0, L_WM = 0, L_XSF = 43008, L_BN = L_XSF + 16384, L_CN = L_BN + 17408, L_HN = L_CN + 17408, L_BHT = L_HN + 17408, L_XDT = L_BHT + 18432, L_DT = L_XDT + 9216, L_ACS = L_DT + 256, L_END = L_ACS + 256;
static_assert(L_END <= LDS_BYTES - 2048, "ssd LDS");
}
__device__ __forceinline__ void ssd_chunk_item(const float* const* in, unsigned char* ws, LAS unsigned char* lds, int item, int tid) {
    using namespace sd;
    const int b = item >> 4, h = item & 15, g = h >> 3, lane = tid & 63, wave = tid >> 6;
    const bf16* P = (const bf16*)(ws + WS_P); float* ssdy = (float*)(ws + WS_SSDY);
    const float* conv_w = in[21]; const float* conv_b = in[22];
    const float dtb = in[23][h], a_h = -expf(in[24][h]), dsk = in[25][h];
    LAS bf16* RAW = (LAS bf16*)(lds + L_RAW); LAS bf16* WM = (LAS bf16*)(lds + L_WM); LAS float* XSF = (LAS float*)(lds + L_XSF);
    LAS bf16* BN = (LAS bf16*)(lds + L_BN); LAS bf16* CN = (LAS bf16*)(lds + L_CN); LAS bf16* HN = (LAS bf16*)(lds + L_HN); LAS bf16* BHT = (LAS bf16*)(lds + L_BHT); LAS bf16* XDT = (LAS bf16*)(lds + L_XDT);
    LAS float* DT = (LAS float*)(lds + L_DT); LAS float* ACS = (LAS float*)(lds + L_ACS);
    const size_t rowbase = (size_t)b * T;
    v4u rr[6]; bf16 rdt = 0;
#define SSD_LOAD(t0_) do { _Pragma("unroll") for (int i = 0; i < 6; ++i) { const int id = tid + 512 * i; const int r = id / 40, cc = id - r * 40, tt = (t0_) - 3 + r; \
            const int col = cc < 8 ? O_XS + h * 64 + 8 * cc : (cc < 24 ? O_B + g * 128 + 8 * (cc - 8) : O_C + g * 128 + 8 * (cc - 24)); \
            rr[i] = (id < 67 * 40 && tt >= 0) ? *(const GAS v4u*)(P + (rowbase + tt) * N_OIN + col) : (v4u){0u, 0u, 0u, 0u}; } \
        if (tid < 64) rdt = P[(rowbase + (t0_) + tid) * N_OIN + O_DT + h]; } while (0)
    for (int i = tid; i < 64 * PS / 2; i += 512) ((LAS unsigned*)HN)[i] = 0u;
    f32x16 Hs;
#pragma unroll
    for (int r = 0; r < 16; ++r) Hs[r] = 0.f;
    const int sb = wave >> 1, pbk = wave & 1;
    const int xp = tid & 63, xseg = tid >> 6;
    const int bs = tid & 127, bseg = tid >> 7;
    const int chx = h * 64 + xp, chb = 1024 + g * 128 + bs, chc = 1280 + g * 128 + bs;
    const float xw0 = conv_w[chx], xw1 = conv_w[1536 + chx], xw2 = conv_w[3072 + chx], xw3 = conv_w[4608 + chx], xcb = conv_b[chx];
    const float bw0 = conv_w[chb], bw1 = conv_w[1536 + chb], bw2 = conv_w[3072 + chb], bw3 = conv_w[4608 + chb], bcb = conv_b[chb];
    const float cw0 = conv_w[chc], cw1 = conv_w[1536 + chc], cw2 = conv_w[3072 + chc], cw3 = conv_w[4608 + chc], ccb = conv_b[chc];
    SSD_LOAD(0);
    for (int c = 0; c < T / 64; ++c) {
        const int t0 = c * 64;
#pragma unroll
        for (int i = 0; i < 6; ++i) { const int id = tid + 512 * i; if (id < 67 * 40) { const int r = id / 40, cc = id - r * 40; *(LAS v4u*)(RAW + r * RAWP + 8 * cc) = rr[i]; } }
        if (tid < 64) { const float dt = softplus_f(bf2f(rdt) + dtb); float v = dt * a_h;
#pragma unroll
            for (int off = 1; off < 64; off <<= 1) { const float u = __shfl_up(v, off); if (lane >= off) v += u; }
            DT[tid] = dt; ACS[tid] = v; }
        __syncthreads();
        if (c + 1 < T / 64) SSD_LOAD(t0 + 64);
        const float acs_last = ACS[63];
        {
            float rw[11];
#pragma unroll
            for (int j = 0; j < 11; ++j) rw[j] = bf2f(RAW[(8 * xseg + j) * RAWP + xp]);
            unsigned pk[4];
#pragma unroll
            for (int i = 0; i < 8; i += 2) { const float x0 = silu_x(xcb + xw0 * rw[i] + xw1 * rw[i + 1] + xw2 * rw[i + 2] + xw3 * rw[i + 3]), x1 = silu_x(xcb + xw0 * rw[i + 1] + xw1 * rw[i + 2] + xw2 * rw[i + 3] + xw3 * rw[i + 4]);
                const int l = 8 * xseg + i; XSF[l * 64 + xp] = x0; XSF[(l + 1) * 64 + xp] = x1; pk[i >> 1] = pk2(x0 * DT[l], x1 * DT[l + 1]); }
            *(LAS v4u*)(XDT + xp * PQ + 8 * xseg) = (v4u){pk[0], pk[1], pk[2], pk[3]};
        }
        {
            float rw[19];
#pragma unroll
            for (int j = 0; j < 19; ++j) rw[j] = bf2f(RAW[(16 * bseg + j) * RAWP + 64 + bs]);
            unsigned pk[8];
#pragma unroll
            for (int i = 0; i < 16; i += 2) { const float v0 = silu_x(bcb + bw0 * rw[i] + bw1 * rw[i + 1] + bw2 * rw[i + 2] + bw3 * rw[i + 3]), v1 = silu_x(bcb + bw0 * rw[i + 1] + bw1 * rw[i + 2] + bw2 * rw[i + 3] + bw3 * rw[i + 4]);
                const int l = 16 * bseg + i; BN[l * PS + bs] = (bf16)f2bf(v0); BN[(l + 1) * PS + bs] = (bf16)f2bf(v1);
                pk[i >> 1] = pk2(v0 * expf(acs_last - ACS[l]), v1 * expf(acs_last - ACS[l + 1])); }
            *(LAS v4u*)(BHT + bs * PQ + 16 * bseg) = (v4u){pk[0], pk[1], pk[2], pk[3]}; *(LAS v4u*)(BHT + bs * PQ + 16 * bseg + 8) = (v4u){pk[4], pk[5], pk[6], pk[7]};
#pragma unroll
            for (int j = 0; j < 19; ++j) rw[j] = bf2f(RAW[(16 * bseg + j) * RAWP + 192 + bs]);
#pragma unroll
            for (int i = 0; i < 16; ++i) { const float v0 = silu_x(ccb + cw0 * rw[i] + cw1 * rw[i + 1] + cw2 * rw[i + 2] + cw3 * rw[i + 3]); CN[(16 * bseg + i) * PS + bs] = (bf16)f2bf(v0); }
        }
        __syncthreads();
        f32x16 yi;
#pragma unroll
        for (int r = 0; r < 16; ++r) yi[r] = 0.f;
        const int lb = (wave & 3) >> 1, qb = wave & 1;
        if (wave < 4) { mm32<128>(yi, CN, PS, 32 * lb, HN, PS, 32 * qb, lane);
#pragma unroll
            for (int r = 0; r < 16; ++r) yi[r] *= expf(ACS[32 * lb + accrow(r, lane)]); }
        else { f32x16 a;
#pragma unroll
            for (int r = 0; r < 16; ++r) a[r] = 0.f;
            if (qb <= lb) mm32<128>(a, CN, PS, 32 * lb, BN, PS, 32 * qb, lane);
            const int mm = 32 * qb + (lane & 31); const float am = ACS[mm];
#pragma unroll
            for (int r = 0; r < 16; ++r) { const int ll = 32 * lb + accrow(r, lane); WM[ll * PQ + mm] = (bf16)f2bf(mm <= ll ? a[r] * expf(ACS[ll] - am) : 0.f); } }
        __syncthreads();
        if (wave < 4) { mm32<64>(yi, WM, PQ, 32 * lb, XDT, PQ, 32 * qb, lane);
            const int pp = 32 * qb + (lane & 31);
#pragma unroll
            for (int r = 0; r < 16; ++r) { const int ll = 32 * lb + accrow(r, lane); ssdy[(rowbase + t0 + ll) * D + h * 64 + pp] = yi[r] + dsk * XSF[ll * 64 + pp]; } }
        { const float cd = expf(acs_last);
#pragma unroll
          for (int r = 0; r < 16; ++r) Hs[r] *= cd;
          mm32<64>(Hs, BHT, PQ, 32 * sb, XDT, PQ, 32 * pbk, lane);
#pragma unroll
          for (int g4 = 0; g4 < 4; ++g4) { v2u w; w.x = pk2(Hs[4 * g4], Hs[4 * g4 + 1]); w.y = pk2(Hs[4 * g4 + 2], Hs[4 * g4 + 3]);
              *(LAS v2u*)(HN + (32 * pbk + (lane & 31)) * PS + 32 * sb + 8 * g4 + 4 * (lane >> 5)) = w; } }
        __syncthreads();
    }
#undef SSD_LOAD
}

namespace rw {
constexpr int TB = 32;
constexpr int O_AV = 0, O_WR = 8192, O_WV = 16384, O_BV = 24576, O_KV = 32768, O_VV = 40960, O_C12 = 43008, O_YB = 43264, BUF = 45312;
static_assert(2 * BUF <= LDS_BYTES - 2048, "rwkv LDS");
}
__device__ __forceinline__ float dpp_row16_sum(float v) {
    v += __builtin_bit_cast(float, __builtin_amdgcn_update_dpp(0, __builtin_bit_cast(int, v), 0xB1, 0xF, 0xF, true));
    v += __builtin_bit_cast(float, __builtin_amdgcn_update_dpp(0, __builtin_bit_cast(int, v), 0x4E, 0xF, 0xF, true));
    v += __builtin_bit_cast(float, __builtin_amdgcn_update_dpp(0, __builtin_bit_cast(int, v), 0x124, 0xF, 0xF, true));
    v += __builtin_bit_cast(float, __builtin_amdgcn_update_dpp(0, __builtin_bit_cast(int, v), 0x128, 0xF, 0xF, true));
    return v;
}
__device__ __forceinline__ void rwkv_scan_item(const float* const* in, unsigned char* ws, LAS unsigned char* lds, int item, int tid) {
    using namespace rw;
    const int b = item >> 5, h = (item >> 2) & 7, rq = item & 3, lane = tid & 63, wave = tid >> 6;
    const bf16* P = (const bf16*)(ws + WS_P); const float* mu = in[27];
    const float* DEC = (const float*)(ws + WS_DEC); const float* AA = (const float*)(ws + WS_AA);
    float* yraw = (float*)(ws + WS_YRAW); float* BS = (float*)(ws + WS_BS);
    const size_t rowbase = (size_t)b * T;
    if (wave >= 4) {
        const int sw = wave - 4, tt = lane >> 4, jq = lane & 15, hc4 = h * 64 + 4 * jq;
        const f32x4 mu_r = *(const GAS f32x4*)(mu + hc4), mu_k = *(const GAS f32x4*)(mu + 512 + hc4), mu_v = *(const GAS f32x4*)(mu + 1024 + hc4);
        const f32x4 kk_c = *(const GAS f32x4*)(in[33] + hc4), ka_c = *(const GAS f32x4*)(in[34] + hc4), rk_c = *(const GAS f32x4*)(in[35] + hc4);
        for (int blk = 0; blk <= T / TB + 1; ++blk) {
            if (blk < T / TB) {
                LAS unsigned char* B = lds + (blk & 1) * BUF;
                LAS float* AV = (LAS float*)(B + O_AV); LAS float* WR = (LAS float*)(B + O_WR); LAS float* WV = (LAS float*)(B + O_WV); LAS float* BV = (LAS float*)(B + O_BV); LAS float* KV = (LAS float*)(B + O_KV);
                LAS float* VV = (LAS float*)(B + O_VV); LAS float* C12 = (LAS float*)(B + O_C12);
                v2u cr[2], ck[2], cv[2], pr_[2], pk_[2], pv_[2]; f32x4 aa4[2], dd4[2];
#pragma unroll
                for (int ps = 0; ps < 2; ++ps) { const int t = sw * 8 + ps * 4 + tt, tg = blk * TB + t; const size_t m = rowbase + tg; const bf16* pr = P + m * N_OIN + O_R + hc4; const bf16* pp = (tg > 0) ? pr - N_OIN : pr;
                    cr[ps] = *(const GAS v2u*)(pr); ck[ps] = *(const GAS v2u*)(pr + 512); cv[ps] = *(const GAS v2u*)(pr + 1024);
                    pr_[ps] = *(const GAS v2u*)(pp); pk_[ps] = *(const GAS v2u*)(pp + 512); pv_[ps] = *(const GAS v2u*)(pp + 1024);
                    aa4[ps] = *(const GAS f32x4*)(AA + m * 512 + hc4); dd4[ps] = *(const GAS f32x4*)(DEC + m * 512 + hc4); }
#pragma unroll
                for (int ps = 0; ps < 2; ++ps) { const int t = sw * 8 + ps * 4 + tt, tg = blk * TB + t; const size_t m = rowbase + tg; const float hp = tg > 0 ? 1.0f : 0.0f;
                    const f32x4 rc = (f32x4){__uint_as_float(cr[ps].x << 16), __uint_as_float(cr[ps].x & 0xffff0000u), __uint_as_float(cr[ps].y << 16), __uint_as_float(cr[ps].y & 0xffff0000u)};
                    const f32x4 kc = (f32x4){__uint_as_float(ck[ps].x << 16), __uint_as_float(ck[ps].x & 0xffff0000u), __uint_as_float(ck[ps].y << 16), __uint_as_float(ck[ps].y & 0xffff0000u)};
                    const f32x4 vc = (f32x4){__uint_as_float(cv[ps].x << 16), __uint_as_float(cv[ps].x & 0xffff0000u), __uint_as_float(cv[ps].y << 16), __uint_as_float(cv[ps].y & 0xffff0000u)};
                    const f32x4 rp = (f32x4){__uint_as_float(pr_[ps].x << 16), __uint_as_float(pr_[ps].x & 0xffff0000u), __uint_as_float(pr_[ps].y << 16), __uint_as_float(pr_[ps].y & 0xffff0000u)} * hp;
                    const f32x4 kp = (f32x4){__uint_as_float(pk_[ps].x << 16), __uint_as_float(pk_[ps].x & 0xffff0000u), __uint_as_float(pk_[ps].y << 16), __uint_as_float(pk_[ps].y & 0xffff0000u)} * hp;
                    const f32x4 vp = (f32x4){__uint_as_float(pv_[ps].x << 16), __uint_as_float(pv_[ps].x & 0xffff0000u), __uint_as_float(pv_[ps].y << 16), __uint_as_float(pv_[ps].y & 0xffff0000u)} * hp;
                    const f32x4 r_ = rc + (rp - rc) * mu_r, k_ = kc + (kp - kc) * mu_k, v_ = vc + (vp - vc) * mu_v, a_ = aa4[ps], d_ = dd4[ps];
                    const f32x4 kkr = k_ * kk_c; const float n2 = dpp_row16_sum((kkr.x * kkr.x + kkr.y * kkr.y) + (kkr.z * kkr.z + kkr.w * kkr.w));
                    const f32x4 kk = kkr * (1.0f / fmaxf(sqrtf(n2), 1e-12f));
                    const f32x4 k2 = k_ * ((a_ - 1.0f) * ka_c + 1.0f), bv = kk * a_, br = bv * r_, kr = k2 * r_, bb = kr * rk_c;
                    *(LAS f32x4*)(AV + t * 64 + 4 * jq) = -kk; *(LAS f32x4*)(WR + t * 64 + 4 * jq) = d_ * r_; *(LAS f32x4*)(WV + t * 64 + 4 * jq) = d_; *(LAS f32x4*)(BV + t * 64 + 4 * jq) = bv; *(LAS f32x4*)(KV + t * 64 + 4 * jq) = k2;
                    if ((jq >> 2) == rq) *(LAS f32x4*)(VV + t * 16 + 4 * (jq & 3)) = v_;
                    const float c1 = dpp_row16_sum((br.x + br.y) + (br.z + br.w)), c2 = dpp_row16_sum((kr.x + kr.y) + (kr.z + kr.w)), bsum = dpp_row16_sum((bb.x + bb.y) + (bb.z + bb.w));
                    if (jq == 0) { C12[2 * t] = c1; C12[2 * t + 1] = c2; if (rq == 0) BS[m * 8 + h] = bsum; } }
            }
            if (blk > 1) {
                const LAS float* YB = (const LAS float*)(lds + (blk & 1) * BUF + O_YB);
                const int t = (tid - 256) >> 3, ii = ((tid - 256) & 7) * 2;
                const size_t m = rowbase + (blk - 2) * TB + t; float2 v; v.x = YB[t * 16 + ii]; v.y = YB[t * 16 + ii + 1];
                *(float2*)(yraw + m * 512 + h * 64 + 16 * rq + ii) = v;
            }
            __syncthreads();
        }
    } else {
        const int il = 4 * wave + (lane >> 4), j = lane & 15;
        f32x4 S = (f32x4){0.f, 0.f, 0.f, 0.f};
        __syncthreads();
        for (int blk = 0; blk < T / TB; ++blk) {
            const LAS unsigned char* B = lds + (blk & 1) * BUF;
            const LAS float* AV = (const LAS float*)(B + O_AV); const LAS float* WR = (const LAS float*)(B + O_WR); const LAS float* WV = (const LAS float*)(B + O_WV); const LAS float* BV = (const LAS float*)(B + O_BV); const LAS float* KV = (const LAS float*)(B + O_KV);
            const LAS float* VV = (const LAS float*)(B + O_VV); const LAS float* C12 = (const LAS float*)(B + O_C12); LAS float* YB = (LAS float*)(lds + (blk & 1) * BUF + O_YB);
            f32x4 a4 = *(const LAS f32x4*)(AV + 4 * j), wr4 = *(const LAS f32x4*)(WR + 4 * j), w4 = *(const LAS f32x4*)(WV + 4 * j), b4 = *(const LAS f32x4*)(BV + 4 * j), k4 = *(const LAS f32x4*)(KV + 4 * j);
            float vv = VV[il]; float c1 = C12[0], c2 = C12[1];
#pragma unroll 4
            for (int t = 0; t < TB; ++t) {
                const int tn = (t + 1 < TB) ? t + 1 : t;
                const f32x4 na4 = *(const LAS f32x4*)(AV + tn * 64 + 4 * j), nwr4 = *(const LAS f32x4*)(WR + tn * 64 + 4 * j), nw4 = *(const LAS f32x4*)(WV + tn * 64 + 4 * j), nb4 = *(const LAS f32x4*)(BV + tn * 64 + 4 * j), nk4 = *(const LAS f32x4*)(KV + tn * 64 + 4 * j);
                const float nvv = VV[tn * 16 + il], nc1 = C12[2 * tn], nc2 = C12[2 * tn + 1];
                float psa = (S.x * a4.x + S.y * a4.y) + (S.z * a4.z + S.w * a4.w);
                float py = (S.x * wr4.x + S.y * wr4.y) + (S.z * wr4.z + S.w * wr4.w);
                const f32x4 tmp = S * w4 + k4 * vv;
                psa = dpp_row16_sum(psa); py = dpp_row16_sum(py);
                S = tmp + b4 * psa;
                const float y = py + psa * c1 + vv * c2;
                YB[t * 16 + il] = y;
                a4 = na4; wr4 = nwr4; w4 = nw4; b4 = nb4; k4 = nk4; vv = nvv; c1 = nc1; c2 = nc2;
            }
            __syncthreads();
        }
        __syncthreads();
    }
}
__device__ __forceinline__ void mix1_rows(const float* const* in, unsigned char* ws, int gw, int NGW, int lane) {
    ssd_norm_rows(in, ws, gw, NGW, lane);
    const bf16* P = (const bf16*)(ws + WS_P); const float* mu = in[27]; bf16* mix = (bf16*)(ws + WS_MIX1);
    const float* yraw = (const float*)(ws + WS_YRAW); const float* BS = (const float*)(ws + WS_BS); const float* GG = (const float*)(ws + WS_GG);
    for (int m = gw; m < M; m += NGW) {
        const bool hp = (m % T) != 0;
#pragma unroll 2
        for (int hh = 0; hh < 8; ++hh) { const int hc = hh * 64 + lane;
            const float y = yraw[(size_t)m * 512 + hc]; const float mean = wave_sum(y) * (1.0f / 64.0f); const float dv = y - mean; const float var = wave_sum(dv * dv) * (1.0f / 64.0f);
            const float yn = dv * (1.0f / sqrtf(var + 64e-5f)) * in[36][hc] + in[37][hc];
            const float vc = bf2f(P[(size_t)m * N_OIN + O_R + 1024 + hc]), vp = hp ? bf2f(P[(size_t)(m - 1) * N_OIN + O_R + 1024 + hc]) : 0.f; const float v_ = vc + (vp - vc) * mu[1024 + hc];
            mix[(size_t)m * K_OOUT + 1024 + hc] = (bf16)f2bf((yn + BS[(size_t)m * 8 + hh] * v_) * GG[(size_t)m * 512 + hc]); }
    }
}

struct Args { const float* in[47]; float* out; unsigned char* ws; };
__global__ void __launch_bounds__(NWAVES * 64, 2) fwd_kernel(Args args) {
    extern __shared__ __attribute__((aligned(16))) unsigned char lds_raw[];
    LAS unsigned char* lds = (LAS unsigned char*)lds_raw;
    volatile LAS unsigned* MISC = (volatile LAS unsigned*)(lds + MISC_OFF);
    LAS int* PE = (LAS int*)(lds + PE_OFF);
    LAS float* Lf = (LAS float*)(lds + RING_OFF);
    const int tid = threadIdx.x, lane = tid & 63, wave = __builtin_amdgcn_readfirstlane(tid >> 6);
    const int G = gridDim.x, bid = blockIdx.x, gw = bid * NWAVES + wave, NGW = G * NWAVES;
    unsigned char* ws = args.ws; const float* const* in = args.in;
    gu32* ctl = (gu32*)(ws + WS_CTL);
    for (int u = tid; u < (LDS_BYTES - LDSCTL_OFF) / 4; u += NWAVES * 64) ((LAS unsigned*)(lds + LDSCTL_OFF))[u] = 0u;
    __syncthreads();
    XcdBarrier bar = xcd_barrier_post((unsigned*)(ctl + CW_BAR), MISC + 8);
#define GRID_BAR() xcd_barrier(bar)
    bf16* XBF = (bf16*)(ws + WS_XBF); bf16* PB = (bf16*)(ws + WS_P); float* Y = (float*)(ws + WS_Y);

#if !defined(ONLY) || ONLY==0
    {
    {
        LAS float* scr = Lf + wave * (64 * 33);
        for (int it = gw; it < IT_SMALL; it += NGW) cvt_small_item(in, ws, it, scr, lane);
        bf16* WE = (bf16*)(ws + WS_WEIN);
        for (int idx = bid * 512 + tid; idx < 256 * 1024; idx += G * 512) { const int k = idx & 1023, n = idx >> 10; float s = 0.f;
#pragma unroll
            for (int r = 0; r < 16; ++r) s += in[1][(size_t)k * 2576 + 1536 + r] * in[2][r * 256 + n];
            WE[(size_t)(E_GK + n) * D + k] = (bf16)f2bf(s); }
        for (size_t idx = (size_t)bid * 512 + tid; idx < (size_t)M * D / 4; idx += (size_t)G * 512) { const f32x4 v = ((const GAS f32x4*)in[0])[idx]; v2u o; o.x = pk2(v.x, v.y); o.y = pk2(v.z, v.w); ((GAS v2u*)XBF)[idx] = o; }
    }
    GRID_BAR();
    }
#endif
#if !defined(ONLY) || ONLY==1
    {
    { pg8::Gemm g{XBF, (const bf16*)(ws + WS_WEIN), M, N_EIN, D}; pg8::StaticOrder S; S.init(M, N_EIN, G, bid); pg8::EpiStoreBf16 E{PB, N_EIN};
      pg8::gemm_phase<pg8::EpiStoreBf16, pg8::StaticOrder, true, true>(lds + RING_OFF, g, S, E); }
    GRID_BAR();
    }
#endif
#if !defined(ONLY) || ONLY==2
    {
    for (int it = bid; it < 32; it += G) gla_chunk_item(in, ws, lds, it, tid);
    for (int it = bid - 32; it < 64; it += G) if (it >= 0) lru_chunk_item(in, ws, lds, it, tid);
    GRID_BAR();
    }
#endif
#if !defined(ONLY) || ONLY==3
    {
    { pg8::Gemm g{(const bf16*)(ws + WS_MIX0), (const bf16*)(ws + WS_WEOUT), M, D, D}; pg8::StaticOrder S; S.init(M, D, G, bid); pg8::EpiStoreF32 E{Y, D};
      pg8::gemm_phase<pg8::EpiStoreF32, pg8::StaticOrder, true, true>(lds + RING_OFF, g, S, E); }
    GRID_BAR();
    }
#endif
#if !defined(ONLY) || ONLY==4
    {
    ln_rows<0>(in[0], Y, in[13], in[14], args.out, XBF, nullptr, ws, ctl, gw, NGW, lane);
    GRID_BAR();
    }
#endif
#if !defined(ONLY) || ONLY==5
    {
    { pg8::Gemm g{XBF, (const bf16*)(ws + WS_WF13), M, N_F13, D}; pg8::StaticOrder S; S.init(M, N_F13, G, bid); pg8::EpiSwiGLU E{PB, FF};
      pg8::gemm_phase<pg8::EpiSwiGLU, pg8::StaticOrder, true, true>(lds + RING_OFF, g, S, E); }
    GRID_BAR();
    }
#endif
#if !defined(ONLY) || ONLY==6
    {
    { pg8::Gemm g{PB, (const bf16*)(ws + WS_WF2), M, D, FF}; pg8::StaticOrder S; S.init(M, D, G, bid); pg8::EpiStoreF32 E{Y, D};
      pg8::gemm_phase<pg8::EpiStoreF32, pg8::StaticOrder, true, true>(lds + RING_OFF, g, S, E); }
    GRID_BAR();
    }
#endif
#if !defined(ONLY) || ONLY==7
    {
    ln_rows<0>(args.out, Y, in[18], in[19], args.out, XBF, nullptr, ws, ctl, gw, NGW, lane);
    GRID_BAR();
    }
#endif
#if !defined(ONLY) || ONLY==8
    {
    { pg8::Gemm g{XBF, (const bf16*)(ws + WS_WOIN), M, N_OIN, D}; pg8::StaticOrder S; S.init(M, N_OIN, G, bid); pg8::EpiStoreBf16 E{PB, N_OIN};
      pg8::gemm_phase<pg8::EpiStoreBf16, pg8::StaticOrder, true, true>(lds + RING_OFF, g, S, E); }
    GRID_BAR();
    }
#endif
#if !defined(ONLY) || ONLY==9
    {
    if (bid < 128) ssd_chunk_item(in, ws, lds, bid, tid);
    else { for (int tl = bid - 128; tl < 512; tl += G - 128) rwkv_pre_tile(in, ws, Lf, tl, tid); }
    GRID_BAR();
    }
#endif
#if !defined(ONLY) || ONLY==10
    {
    rwkv_scan_item(in, ws, lds, bid, tid);
    GRID_BAR();
    mix1_rows(in, ws, gw, NGW, lane);
    GRID_BAR();
    }
#endif
#if !defined(ONLY) || ONLY==11
    {
    { pg8::Gemm g{(const bf16*)(ws + WS_MIX1), (const bf16*)(ws + WS_WOOUT), M, D, K_OOUT}; pg8::StaticOrder S; S.init(M, D, G, bid); pg8::EpiStoreF32 E{Y, D};
      pg8::gemm_phase<pg8::EpiStoreF32, pg8::StaticOrder, true, true>(lds + RING_OFF, g, S, E); }
    { LAS float* scr = Lf + wave * (64 * 33);
      for (int it = gw; it < IT_EXP; it += NGW) cvt_exp_item(in, ws, it, scr, lane); }
    GRID_BAR();
    }
#endif
#if !defined(ONLY) || ONLY==12
    {
    ln_rows<1>(args.out, Y, in[39], in[40], args.out, XBF, in[41], ws, ctl, gw, NGW, lane);
    GRID_BAR();
    }
#endif
#if !defined(ONLY) || ONLY==13
    {
    {
        if (tid == 0) { int off = 0;
            for (int e = 0; e < NE; ++e) { const int c = (int)__hip_atomic_load(ctl + CW_CNT + 64 * e, RLX_AGENT); const int np = (c + 255) >> 8; PE[160 + e] = off; for (int p = off; p < off + np && p < 160; ++p) PE[p] = e; off += np; }
            PE[168] = off; PE[169] = off; for (int p = off; p < 160; ++p) PE[p] = 0; }
        __syncthreads();
        const int* re = (const int*)(ws + WS_ROUTE + RT_E); const int* rp = (const int*)(ws + WS_ROUTE + RT_P); int* rdst = (int*)(ws + WS_ROUTE + RT_DST); bf16* XY = (bf16*)(ws + WS_XY);
        for (int pr = gw; pr < 2 * M; pr += NGW) { const int e = re[pr], dst = PE[160 + e] * 256 + rp[pr]; const int m = pr >> 1;
            const GAS v4u* src = (const GAS v4u*)(XBF + (size_t)m * D) + lane; GAS v4u* dp = (GAS v4u*)(XY + (size_t)dst * D) + lane;
            dp[0] = src[0]; dp[64] = src[64]; if (lane == 0) rdst[pr] = dst; }
        for (int e = 0; e < NE; ++e) { const int c = (int)__hip_atomic_load(ctl + CW_CNT + 64 * e, RLX_AGENT); const int r0 = PE[160 + e] * 256 + c, r1 = PE[160 + e] * 256 + (((c + 255) >> 8) << 8);
            for (int r = r0 + gw; r < r1; r += NGW) { GAS v4u* dp = (GAS v4u*)(XY + (size_t)r * D) + lane; dp[0] = (v4u){0u, 0u, 0u, 0u}; dp[64] = (v4u){0u, 0u, 0u, 0u}; } }
    }
    GRID_BAR();
    }
#endif
#ifndef NO_MOE
#if !defined(ONLY) || ONLY==14
    {
    {
        const int NP = PE[169]; const int nchunks = (NP + MOE_CP - 1) / MOE_CP;
        for (int c = 0; c <= nchunks; ++c) {
            const int np_up = c < nchunks ? min(MOE_CP, NP - c * MOE_CP) : 0, np_dn = c > 0 ? min(MOE_CP, NP - (c - 1) * MOE_CP) : 0;
            const int nu = np_up * 28, nd = np_dn * 4;
            int Lv = (7 * nd + 2 * nu + G - 1) / G; if (Lv < 0) Lv = 0;
            for (;;) { const int qa_ = Lv > 7 ? (Lv - 7) / 2 : 0, qb_ = Lv / 2; if ((long)nd * qa_ + (long)(G - nd) * qb_ >= nu) break; ++Lv; }
            const int qa = Lv > 7 ? (Lv - 7) / 2 : 0, qb = Lv / 2;
            const int ndc = nd < G ? nd : G;
            const int ustart = bid < ndc ? bid * qa : ndc * qa + (bid - ndc) * qb; int ucount = bid < ndc ? qa : qb; if (ustart + ucount > nu) ucount = nu - ustart; if (ucount < 0) ucount = 0;
            bf16* HEup = (bf16*)(ws + WS_HE + (size_t)(c & 1) * HE_BYTES); const bf16* HEdn = (const bf16*)(ws + WS_HE + (size_t)((c + 1) & 1) * HE_BYTES);
            if (nd > 0) { pg8::Gemm g{HEdn, (const bf16*)(ws + WS_EXP2), 0, D, FE}; pg8::MoeDownOrder S{bid, 0, (c - 1) * MOE_CP, PE};
                int cnt = 0; for (int d = bid; d < nd; d += G) ++cnt; S.count = cnt;
                pg8::EpiStoreBf16 E{(bf16*)(ws + WS_XY), D};
                pg8::gemm_phase<pg8::EpiStoreBf16, pg8::MoeDownOrder, true, true>(lds + RING_OFF, g, S, E); }
            if (nu > 0) { pg8::Gemm g{(const bf16*)(ws + WS_XY), (const bf16*)(ws + WS_EXP13), 0, N_E13, D}; pg8::MoeUpOrder S{ustart, ucount, c * MOE_CP, PE};
                pg8::EpiSwiGLU E{HEup, FE};
                pg8::gemm_phase<pg8::EpiSwiGLU, pg8::MoeUpOrder, true, true>(lds + RING_OFF, g, S, E); }
            GRID_BAR();
        }
    }
    }
#endif
#endif
    ln_rows<2>(args.out, nullptr, in[45], in[46], args.out, nullptr, nullptr, ws, ctl, gw, NGW, lane);
}

extern "C" void kernel_launch(void* const* d_in, const int* in_sizes, int n_in, void* d_out, int out_size, void* d_ws, size_t ws_size, hipStream_t stream) {
    static int grid = 0;
    if (grid == 0) {
        if (n_in != 47 || in_sizes[0] != M * D || out_size != M * D || ws_size < WS_END) { fprintf(stderr, "kernel_launch: unexpected shapes (n_in %d, out %d, ws %zu)\n", n_in, out_size, ws_size); grid = -1; return; }
        int dev = 0, cus = 0, per_cu = 0;
        if (hipGetDevice(&dev) != hipSuccess || hipDeviceGetAttribute(&cus, hipDeviceAttributeMultiprocessorCount, dev) != hipSuccess) { grid = -1; return; }
        if (hipFuncSetAttribute((const void*)fwd_kernel, hipFuncAttributeMaxDynamicSharedMemorySize, LDS_BYTES) != hipSuccess) { fprintf(stderr, "kernel_launch: hipFuncSetAttribute failed\n"); grid = -1; return; }
        if (hipOccupancyMaxActiveBlocksPerMultiprocessor(&per_cu, (const void*)fwd_kernel, NWAVES * 64, LDS_BYTES) != hipSuccess || per_cu < 1) { fprintf(stderr, "kernel_launch: occupancy query reports %d\n", per_cu); }
        (void)hipGetLastError();
        if (cus < 256) { fprintf(stderr, "kernel_launch: built for a 256-CU device, found %d CUs\n", cus); grid = -1; return; }
        grid = 256;
    }
    if (grid < 0) return;
    if (hipMemsetAsync((char*)d_ws + WS_CTL, 0, CTL_ZERO_BYTES, stream) != hipSuccess) return;
    Args a{};
    for (int i = 0; i < 47; ++i) a.in[i] = (const float*)d_in[i];
    a.out = (float*)d_out; a.ws = (unsigned char*)d_ws;
    hipLaunchKernelGGL(fwd_kernel, dim3(grid), dim3(NWAVES * 64), LDS_BYTES, stream, a);
}
```

```cpp
#include <hip/hip_runtime.h>
#include <cstdio>
#include <cstdint>
#include <cmath>
namespace pg8 {
#define PG8_LAS __attribute__((address_space(3)))
typedef unsigned short bf16_t;
typedef short bf16x8 __attribute__((ext_vector_type(8)));
typedef float f32x4 __attribute__((ext_vector_type(4)));
typedef unsigned u32x4 __attribute__((ext_vector_type(4)));
constexpr int BM = 256, BK = 64, HALF = 128, HTB = HALF * BK * 2  , STAGE_BYTES = 8 * HTB, NXCD = 8, WGM = 8;

__host__ __device__ __forceinline__ int lds_byte(int r, int c) { const int st = (r >> 4) * 2 + (c >> 5), rr = r & 15, cc = c & 31, ob = rr * 64 + cc * 2; return st * 1024 + (ob ^ (((ob >> 9) & 1) << 5)); }
__host__ __device__ __forceinline__ void stage_rc(int b, int& R, int& C) { const int st = b / 1024, sb = b % 1024, swz = sb ^ (((sb >> 9) & 1) << 5); R = (st >> 1) * 16 + swz / 64; C = (st & 1) * 32 + (swz % 64) / 2; }
__host__ __device__ __forceinline__ int perm32(int rho) { const int n = rho >> 4, i = rho & 15; return 8 * (i >> 2) + 4 * n + (i & 3); }

struct Unit { int pm, pn, om, on; };
struct Gemm { const bf16_t* A; const bf16_t* Bt; int M, N, K; };

struct StaticOrder {
    int nM, nN, nwg, G, c;
    __host__ __device__ void init(int M, int N, int G_, int c_) { nM = M / BM; nN = N / BM; nwg = nM * nN; G = G_; c = c_; }
    __host__ __device__ bool next(int i, Unit& u) const {
        const long L = (long)i * G + c; if (L >= nwg) return false;
        int wgid = (int)L; { const int q = nwg / NXCD, r = nwg % NXCD, xcd = wgid % NXCD, off = wgid / NXCD; wgid = (xcd < r ? xcd * (q + 1) : r * (q + 1) + (xcd - r) * q) + off; }
        const int nig = WGM * nN, gid = wgid / nig, fm = gid * WGM, gsz = (nM - fm) < WGM ? (nM - fm) : WGM;
        u.pm = fm + ((wgid % nig) % gsz); u.pn = (wgid % nig) / gsz; u.om = u.pm; u.on = u.pn; return true;
    }
    __device__ __forceinline__ void a_ready(const Unit&) const {}
    __device__ __forceinline__ void done(const Unit&) const {}
};
struct MoeUpOrder {
    int start, count, pbase; const PG8_LAS int* pe;
    __device__ __forceinline__ bool next(int i, Unit& u) const { if (i >= count) return false; const int k = start + i, pl = k / 28, j = k - pl * 28, p = pbase + pl, e = pe[p];
        u.pm = p; u.pn = e * 28 + j; u.om = pl; u.on = j; return true; }
    __device__ __forceinline__ void a_ready(const Unit&) const {}
    __device__ __forceinline__ void done(const Unit&) const {}
};
struct MoeDownOrder {
    int start, count, pbase; const PG8_LAS int* pe;
    __device__ __forceinline__ bool next(int i, Unit& u) const { if (i >= count) return false; const int d = start + i, pl = d >> 2, j = d & 3, p = pbase + pl, e = pe[p];
        u.pm = pl; u.pn = e * 4 + j; u.om = p; u.on = j; return true; }
    __device__ __forceinline__ void a_ready(const Unit&) const {}
    __device__ __forceinline__ void done(const Unit&) const {}
};

__device__ __forceinline__ unsigned cvt_pk_bf16(float lo, float hi) { unsigned r; asm volatile("v_cvt_pk_bf16_f32 %0, %1, %2" : "=v"(r) : "v"(lo), "v"(hi)); return r; }

struct EpiStoreF32 {
    static constexpr bool PERM = false, AFTER_DRAIN = false;
    float* C; int ldc;
    __device__ __forceinline__ void operator()(const f32x4 (&acc)[2][2][4][2], const Unit& u, int wr, int wc, int fr, int fq) const {
        const int row0 = u.om * BM + wr * 64 + fr, col0 = u.on * BM + wc * 32 + 4 * fq;
#pragma unroll
        for (int ai = 0; ai < 2; ++ai)
#pragma unroll
            for (int m = 0; m < 4; ++m) { float* rowp = C + (size_t)(row0 + ai * HALF + m * 16) * ldc + col0;
#pragma unroll
                for (int bj = 0; bj < 2; ++bj)
#pragma unroll
                    for (int n = 0; n < 2; ++n) *(f32x4*)(rowp + bj * HALF + n * 16) = acc[ai][bj][m][n]; }
    }
};
struct EpiStoreBf16 {
    static constexpr bool PERM = true, AFTER_DRAIN = false;
    bf16_t* O; int ldc;
    __device__ __forceinline__ void operator()(const f32x4 (&acc)[2][2][4][2], const Unit& u, int wr, int wc, int fr, int fq) const {
        const int row0 = u.om * BM + wr * 64 + fr, col0 = u.on * BM + wc * 32 + 8 * fq;
#pragma unroll
        for (int ai = 0; ai < 2; ++ai)
#pragma unroll
            for (int m = 0; m < 4; ++m) { bf16_t* rowp = O + (size_t)(row0 + ai * HALF + m * 16) * ldc + col0;
#pragma unroll
                for (int bj = 0; bj < 2; ++bj) { const f32x4 v0 = acc[ai][bj][m][0], v1 = acc[ai][bj][m][1];
                    u32x4 w; w.x = cvt_pk_bf16(v0[0], v0[1]); w.y = cvt_pk_bf16(v0[2], v0[3]); w.z = cvt_pk_bf16(v1[0], v1[1]); w.w = cvt_pk_bf16(v1[2], v1[3]);
                    *(u32x4*)(rowp + bj * HALF) = w; } }
    }
};
__device__ __forceinline__ float silu_f(float x) { return x * __builtin_amdgcn_rcpf(1.0f + __builtin_amdgcn_exp2f(-1.4426950408889634f * x)); }
struct EpiSwiGLU {
    static constexpr bool PERM = true, AFTER_DRAIN = false;
    bf16_t* O; int ldc;
    __device__ __forceinline__ void operator()(const f32x4 (&acc)[2][2][4][2], const Unit& u, int wr, int wc, int fr, int fq) const {
        const int row0 = u.om * BM + wr * 64 + fr, col0 = u.on * HALF + wc * 32 + 8 * fq;
#pragma unroll
        for (int ai = 0; ai < 2; ++ai)
#pragma unroll
            for (int m = 0; m < 4; ++m) { bf16_t* rowp = O + (size_t)(row0 + ai * HALF + m * 16) * ldc + col0;
                const f32x4 g0 = acc[ai][0][m][0], g1 = acc[ai][0][m][1], u0 = acc[ai][1][m][0], u1 = acc[ai][1][m][1];
                u32x4 w; w.x = cvt_pk_bf16(silu_f(g0[0]) * u0[0], silu_f(g0[1]) * u0[1]); w.y = cvt_pk_bf16(silu_f(g0[2]) * u0[2], silu_f(g0[3]) * u0[3]);
                w.z = cvt_pk_bf16(silu_f(g1[0]) * u1[0], silu_f(g1[1]) * u1[1]); w.w = cvt_pk_bf16(silu_f(g1[2]) * u1[2], silu_f(g1[3]) * u1[3]);
                *(u32x4*)rowp = w; }
    }
};

template <class Epi, class Sched, bool ALIGN_EPI = false, bool SP2 = false>
__device__ __forceinline__ void gemm_phase(PG8_LAS unsigned char* lds, const Gemm g, const Sched& S, const Epi& E) {
    const int tid = threadIdx.x, wid = __builtin_amdgcn_readfirstlane(tid >> 6), lane = tid & 63, wr = wid >> 2, wc = wid & 3, fr = lane & 15, fq = lane >> 4;
    const int K = g.K, nt = K / BK;
    unsigned voffA[2], voffB[2];
#pragma unroll
    for (int i = 0; i < 2; ++i) { int R, C; stage_rc(tid * 16 + i * 8192, R, C); const int Rb = Epi::PERM ? ((R & ~31) + perm32(R & 31)) : R;
        voffA[i] = (unsigned)(R * K + C) * 2u; voffB[i] = (unsigned)(Rb * K + C) * 2u; }
    const size_t kstep = (size_t)(BK * 2);
    const size_t hstep = (size_t)HALF * K * 2;
    const size_t tstep = 2 * hstep;
    const unsigned ldsw = (unsigned)wid * 1024u;
    const int aoff = lds_byte(wr * 64 + fr, fq * 8), boff = lds_byte(wc * 32 + fr, fq * 8);
#define PG8_SA(b, h) (((b) * 2 + (h)) * HTB)
#define PG8_SB(b, h) ((4 + (b) * 2 + (h)) * HTB)
#define PG8_STAGE(bufoff, gbase, voff) do { _Pragma("unroll") for (int _i = 0; _i < 2; ++_i) \
        __builtin_amdgcn_global_load_lds((const unsigned*)((const char*)(gbase) + (voff)[_i]), (PG8_LAS unsigned*)(lds + (bufoff) + ldsw + _i * 8192), 16, 0, 0); } while (0)
#define PG8_LDA(dst, b, h) do { _Pragma("unroll") for (int m = 0; m < 4; ++m) _Pragma("unroll") for (int k = 0; k < 2; ++k) dst[m][k] = *(const PG8_LAS bf16x8*)(lds + PG8_SA(b, h) + aoff + m * 2048 + k * 1024); } while (0)
#define PG8_LDB(dst, b, h) do { _Pragma("unroll") for (int n = 0; n < 2; ++n) _Pragma("unroll") for (int k = 0; k < 2; ++k) dst[n][k] = *(const PG8_LAS bf16x8*)(lds + PG8_SB(b, h) + boff + n * 2048 + k * 1024); } while (0)
#define PG8_MMA(ai, bj, At, Bt) do { __builtin_amdgcn_s_setprio(1); _Pragma("unroll") for (int m = 0; m < 4; ++m) _Pragma("unroll") for (int n = 0; n < 2; ++n) _Pragma("unroll") for (int k = 0; k < 2; ++k) \
        acc[ai][bj][m][n] = __builtin_amdgcn_mfma_f32_16x16x32_bf16(Bt[n][k], At[m][k], acc[ai][bj][m][n], 0, 0, 0); __builtin_amdgcn_s_setprio(0); } while (0)
#define PG8_WAIT_V(n) asm volatile("s_waitcnt vmcnt(" #n ")" ::: "memory")
#define PG8_WAIT_L(n) asm volatile("s_waitcnt lgkmcnt(" #n ")" ::: "memory")
#define PG8_BAR __builtin_amdgcn_s_barrier()
#define PG8_SCHED __builtin_amdgcn_sched_barrier(0)
    Unit cur, nxt; int ui = 0;
    if (!S.next(0, cur)) return;
    f32x4 acc[2][2][4][2];
#pragma unroll
    for (int a = 0; a < 2; ++a)
#pragma unroll
        for (int b = 0; b < 2; ++b)
#pragma unroll
            for (int m = 0; m < 4; ++m)
#pragma unroll
                for (int n = 0; n < 2; ++n) acc[a][b][m][n] = (f32x4){0.f, 0.f, 0.f, 0.f};
    bf16x8 At[4][2], B0[2][2], B1[2][2];
    const char* cA = (const char*)g.A + (size_t)cur.pm * tstep; const char* cB = (const char*)g.Bt + (size_t)cur.pn * tstep;
    S.a_ready(cur);
    if constexpr (SP2) {
        PG8_STAGE(PG8_SB(0, 0), cB, voffB); PG8_STAGE(PG8_SB(0, 1), cB + hstep, voffB); PG8_STAGE(PG8_SA(0, 0), cA, voffA); PG8_STAGE(PG8_SA(0, 1), cA + hstep, voffA);
        if (wr == 1) PG8_BAR;
        PG8_WAIT_V(2); PG8_BAR;
        PG8_STAGE(PG8_SB(1, 0), cB + kstep, voffB); PG8_STAGE(PG8_SA(1, 0), cA + kstep, voffA); PG8_STAGE(PG8_SB(1, 1), cB + hstep + kstep, voffB);
        PG8_WAIT_V(6); PG8_BAR;
    } else {
        PG8_STAGE(PG8_SB(0, 0), cB, voffB); PG8_STAGE(PG8_SA(0, 0), cA, voffA); PG8_STAGE(PG8_SB(0, 1), cB + hstep, voffB); PG8_STAGE(PG8_SA(0, 1), cA + hstep, voffA);
        if (wr == 1) PG8_BAR;
        PG8_WAIT_V(4); PG8_BAR;
        PG8_STAGE(PG8_SB(1, 0), cB + kstep, voffB); PG8_STAGE(PG8_SA(1, 0), cA + kstep, voffA); PG8_STAGE(PG8_SB(1, 1), cB + hstep + kstep, voffB);
        PG8_WAIT_V(6); PG8_BAR;
    }
    for (;;) {
        const bool has_next = S.next(ui + 1, nxt);
        const char* nA = has_next ? (const char*)g.A + (size_t)nxt.pm * tstep : cA; const char* nB = has_next ? (const char*)g.Bt + (size_t)nxt.pn * tstep : cB;
        for (int t = 0; t < nt; t += 2) {
            const bool last = (t == nt - 2);
            const char* a1 = cA + (size_t)(t + 1) * kstep;
            const char* a2 = last ? nA : cA + (size_t)(t + 2) * kstep; const char* b2 = last ? nB : cB + (size_t)(t + 2) * kstep;
            const char* a3 = a2 + kstep; const char* b3 = b2 + kstep;
            if (last && has_next) S.a_ready(nxt);
            if constexpr (SP2) {
            PG8_LDB(B0, 0, 0); PG8_LDB(B1, 0, 1); PG8_SCHED; PG8_LDA(At, 0, 0); PG8_STAGE(PG8_SA(1, 1), a1 + hstep, voffA);
            PG8_WAIT_V(8); PG8_WAIT_L(0); PG8_BAR; PG8_MMA(0, 0, At, B0); PG8_MMA(0, 1, At, B1); PG8_BAR; PG8_SCHED;
            PG8_LDA(At, 0, 1); PG8_STAGE(PG8_SB(0, 0), b2, voffB); PG8_STAGE(PG8_SB(0, 1), b2 + hstep, voffB); PG8_STAGE(PG8_SA(0, 0), a2, voffA);
            PG8_WAIT_V(8); PG8_WAIT_L(0); PG8_BAR; PG8_MMA(1, 0, At, B0); PG8_MMA(1, 1, At, B1); PG8_BAR; PG8_SCHED;
            PG8_LDB(B0, 1, 0); PG8_LDB(B1, 1, 1); PG8_SCHED; PG8_LDA(At, 1, 0); PG8_STAGE(PG8_SA(0, 1), a2 + hstep, voffA);
            PG8_WAIT_V(8); PG8_WAIT_L(0); PG8_BAR; PG8_MMA(0, 0, At, B0); PG8_MMA(0, 1, At, B1); PG8_BAR; PG8_SCHED;
            PG8_LDA(At, 1, 1); PG8_STAGE(PG8_SB(1, 0), b3, voffB); PG8_STAGE(PG8_SB(1, 1), b3 + hstep, voffB); PG8_STAGE(PG8_SA(1, 0), a3, voffA);
            PG8_WAIT_V(8); PG8_WAIT_L(0); PG8_BAR; PG8_MMA(1, 0, At, B0); PG8_MMA(1, 1, At, B1); PG8_BAR; PG8_SCHED;
            } else {
            PG8_LDB(B0, 0, 0); PG8_SCHED; PG8_LDA(At, 0, 0); PG8_STAGE(PG8_SA(1, 1), a1 + hstep, voffA);
            PG8_WAIT_L(8); PG8_BAR; PG8_WAIT_L(0); PG8_MMA(0, 0, At, B0); PG8_BAR; PG8_SCHED;
            PG8_LDB(B1, 0, 1); PG8_STAGE(PG8_SB(0, 0), b2, voffB);
            PG8_BAR; PG8_WAIT_L(0); PG8_MMA(0, 1, At, B1); PG8_BAR;
            PG8_LDA(At, 0, 1); PG8_STAGE(PG8_SA(0, 0), a2, voffA);
            PG8_BAR; PG8_WAIT_L(0); PG8_MMA(1, 0, At, B0); PG8_BAR; PG8_SCHED;
            PG8_STAGE(PG8_SB(0, 1), b2 + hstep, voffB);
            PG8_WAIT_V(6); PG8_BAR; PG8_MMA(1, 1, At, B1); PG8_BAR;
            PG8_LDB(B0, 1, 0); PG8_SCHED; PG8_LDA(At, 1, 0); PG8_STAGE(PG8_SA(0, 1), a2 + hstep, voffA);
            PG8_WAIT_L(8); PG8_BAR; PG8_WAIT_L(0); PG8_MMA(0, 0, At, B0); PG8_BAR; PG8_SCHED;
            PG8_LDB(B1, 1, 1); PG8_STAGE(PG8_SB(1, 0), b3, voffB);
            PG8_BAR; PG8_WAIT_L(0); PG8_MMA(0, 1, At, B1); PG8_BAR;
            PG8_LDA(At, 1, 1); PG8_STAGE(PG8_SA(1, 0), a3, voffA);
            PG8_BAR; PG8_WAIT_L(0); PG8_MMA(1, 0, At, B0); PG8_BAR; PG8_SCHED;
            PG8_STAGE(PG8_SB(1, 1), b3 + hstep, voffB);
            PG8_WAIT_V(6); PG8_BAR; PG8_MMA(1, 1, At, B1); PG8_BAR;
            }
        }
        if constexpr (ALIGN_EPI) { if (wr == 0) PG8_BAR; }
        if constexpr (!Epi::AFTER_DRAIN) { E(acc, cur, wr, wc, fr, fq); S.done(cur); }
        if (!has_next) break;
#pragma unroll
        for (int a = 0; a < 2; ++a)
#pragma unroll
            for (int b = 0; b < 2; ++b)
#pragma unroll
                for (int m = 0; m < 4; ++m)
#pragma unroll
                    for (int n = 0; n < 2; ++n) acc[a][b][m][n] = (f32x4){0.f, 0.f, 0.f, 0.f};
        cur = nxt; cA = nA; cB = nB; ++ui;
        if constexpr (ALIGN_EPI) { if (wr == 1) PG8_BAR; }
    }
    PG8_WAIT_V(0);
    if constexpr (!ALIGN_EPI) { if (wr == 0) PG8_BAR; }
    PG8_BAR;
    if constexpr (Epi::AFTER_DRAIN) { E.fused(acc, cur, wr, wc, fr, fq, lds, wid, lane); S.done(cur); }
#undef PG8_SA
#undef PG8_SB
#undef PG8_STAGE
#undef PG8_LDA
#undef PG8_LDB
#undef PG8_MMA
#undef PG8_WAIT_V
#undef PG8_WAIT_L
#undef PG8_BAR
#undef PG8_SCHED
}
}

constexpr int NB = 8, T = 2048, D = 1024, M = NB * T;
constexpr int N_EIN = 2816;
constexpr int E_Q = 0, E_K = 256, E_V = 512, E_G = 1024, E_GK = 1536, E_XB = 1792, E_GATE = 2304;
constexpr int FF = 2816, N_F13 = 2 * FF;
constexpr int N_OIN = 4608;
constexpr int O_Z = 0, O_XS = 1024, O_B = 2048, O_C = 2304, O_R = 2560, O_DT = 4352;
constexpr int K_OOUT = 1536, NE = 8, FE = 3584, N_E13 = 2 * FE  ;
constexpr int MOE_MAXP = 136, MOE_CP = 32;
constexpr float LN_EPS = 1e-5f, ALPHA = 1.4142135623730951f;

constexpr size_t MiB = 1u << 20;
constexpr size_t WS_CTL = 0, CTL_ZERO_BYTES = 1 * MiB;
constexpr size_t WS_WEIN = 1 * MiB;
constexpr size_t WS_WEOUT = WS_WEIN + (size_t)N_EIN * D * 2;
constexpr size_t WS_WF13 = WS_WEOUT + (size_t)D * D * 2;
constexpr size_t WS_WF2 = WS_WF13 + (size_t)N_F13 * D * 2;
constexpr size_t WS_WOIN = WS_WF2 + (size_t)D * FF * 2;
constexpr size_t WS_WOOUT = WS_WOIN + (size_t)N_OIN * D * 2;
constexpr size_t WS_ROUTE = 37 * MiB;
constexpr size_t WS_LW2 = WS_ROUTE + 512 * 1024, WS_LA2 = WS_LW2 + 65536, WS_LG2 = WS_LA2 + 65536;
constexpr size_t WS_EXP13 = 38 * MiB;
constexpr size_t WS_EXP2 = 150 * MiB;
constexpr size_t WS_DEC = 150 * MiB, WS_AA = 182 * MiB, WS_GG = 214 * MiB, WS_SSDY = 382 * MiB;
constexpr size_t WS_YRAW = 1 * MiB, WS_BS = 33 * MiB;
constexpr size_t WS_XBF = 206 * MiB;
constexpr size_t WS_P = 238 * MiB;
constexpr size_t WS_MIX0 = 326 * MiB;
constexpr size_t WS_Y = 358 * MiB;
constexpr size_t WS_MIX1 = 422 * MiB;
constexpr size_t WS_XY = 238 * MiB;
constexpr size_t WS_HE = 306 * MiB, HE_BYTES = (size_t)MOE_CP * 256 * FE * 2;
constexpr size_t WS_END = 470 * MiB;
static_assert(WS_WOOUT + (size_t)D * K_OOUT * 2 <= WS_ROUTE && WS_P + (size_t)M * N_OIN * 2 <= WS_MIX1 && WS_HE + 2 * HE_BYTES <= WS_MIX1 && WS_MIX1 + (size_t)M * K_OOUT * 2 <= WS_END, "d_ws map");
static_assert(WS_XY + (size_t)MOE_MAXP * 256 * D * 2 <= WS_HE && WS_EXP2 + (size_t)NE * D * FE * 2 <= WS_XBF, "d_ws map 2");
constexpr size_t RT_E = 0, RT_P = 128 * 1024, RT_W = 256 * 1024, RT_DST = 384 * 1024;
constexpr int CW_TMO = 0, CW_CODE = 1, CW_BAR = 4096, CW_CNT = 16384;

constexpr int NWAVES = 8;
constexpr int RING_OFF = 0, RING_BYTES = 131072;
constexpr int LDS_BYTES = 147456;
constexpr int LDSCTL_OFF = LDS_BYTES - 2048, MISC_OFF = LDSCTL_OFF + 320, PE_OFF = MISC_OFF + 128;
static_assert(PE_OFF + 4 * 192 <= LDS_BYTES, "LDS map");

#define GAS __attribute__((address_space(1)))
#define LAS __attribute__((address_space(3)))
typedef unsigned short bf16;
typedef unsigned v4u __attribute__((ext_vector_type(4)));
typedef unsigned v2u __attribute__((ext_vector_type(2)));
typedef float f32x4 __attribute__((ext_vector_type(4)));
typedef GAS unsigned gu32;
#define RLX_AGENT __ATOMIC_RELAXED, __HIP_MEMORY_SCOPE_AGENT
#define LDS_WAIT() asm volatile("s_waitcnt lgkmcnt(0)" ::: "memory")
#define VM_WAIT() asm volatile("s_waitcnt vmcnt(0)" ::: "memory")
__device__ __forceinline__ unsigned f2bf(float f) { unsigned u = __builtin_bit_cast(unsigned, f); return (u + 0x7fffu + ((u >> 16) & 1u)) >> 16; }
__device__ __forceinline__ unsigned pk2(float lo, float hi) { return f2bf(lo) | (f2bf(hi) << 16); }

#define XB_TMO      128
#define XB_XCNT(j)  (256  + 64 * (j))
#define XB_XSUB(j)  (1280 + 64 * (j))
#define XB_XGEN(j)  (2304 + 64 * (j))
#define XB_TOP      3328
#define XB_TOPGEN   3392
#define XCD_BAR_WORDS 3456
#define XB_SPIN_CAP (1u << 18)

__device__ __forceinline__ unsigned xb_ld(unsigned* p)              { return __hip_atomic_load(p, __ATOMIC_RELAXED, __HIP_MEMORY_SCOPE_AGENT); }
__device__ __forceinline__ unsigned xb_add(unsigned* p, unsigned v) { return __hip_atomic_fetch_add(p, v, __ATOMIC_RELAXED, __HIP_MEMORY_SCOPE_AGENT); }
__device__ __forceinline__ unsigned xb_xcc_id() { return (unsigned)__builtin_amdgcn_s_getreg((3 << 11) | 20) & 0xFu; }
#define XB_SPIN(cond, bar) do { unsigned _sp = 0; while (cond) { __builtin_amdgcn_s_sleep(1); \
    if ((++_sp & 255u) == 0u) { if (xb_ld(&(bar)[XB_TMO])) break; if (_sp > XB_SPIN_CAP) { atomicAdd(&(bar)[XB_TMO], 1u); break; } } } } while (0)

struct XcdBarrier {
    unsigned* bar; unsigned x;
    volatile LAS unsigned* st;
};

__device__ __forceinline__ XcdBarrier xcd_barrier_post(unsigned* bar, volatile LAS unsigned* st) {
    XcdBarrier b; b.bar = bar; b.x = xb_xcc_id(); b.st = st;
    if (threadIdx.x == 0) (void)xb_add(&bar[XB_XCNT(b.x)], 1u);
    return b;
}
__device__ __forceinline__ void xcd_barrier_complete(unsigned* bar, unsigned x, unsigned& nloc, unsigned& nx) {
    const unsigned G = gridDim.x * gridDim.y * gridDim.z;
    unsigned sum, cnt, mine, sp = 0u;
    for (;;) {
        sum = 0u; cnt = 0u; mine = 0u;
#pragma unroll
        for (unsigned j = 0; j < 16; ++j) { const unsigned c = xb_ld(&bar[XB_XCNT(j)]); sum += c; cnt += (c > 0u) ? 1u : 0u; mine = (j == x) ? c : mine; }
        if (sum == G) break;
        __builtin_amdgcn_s_sleep(1);
        if ((++sp & 255u) == 0u) { if (xb_ld(&bar[XB_TMO])) break; if (sp > XB_SPIN_CAP) { atomicAdd(&bar[XB_TMO], 1u); break; } }
    }
    nloc = mine > 0u ? mine : 1u; nx = cnt > 0u ? cnt : 1u;
}

__device__ __forceinline__ void xcd_barrier(const XcdBarrier& b) {
    asm volatile("s_waitcnt vmcnt(0)" ::: "memory");
    __syncthreads();
    if (threadIdx.x == 0) {
        unsigned* bar = b.bar;
        __builtin_amdgcn_s_waitcnt(0);
        unsigned nloc = b.st[0], nx = b.st[1];
        if (nloc == 0u) { xcd_barrier_complete(bar, b.x, nloc, nx); b.st[0] = nloc; b.st[1] = nx; }
        const unsigned old = xb_add(&bar[XB_XSUB(b.x)], 1u);
        const unsigned gen = old / nloc;
        if (old + 1u == (gen + 1u) * nloc) {
            __builtin_amdgcn_fence(__ATOMIC_RELEASE, "agent");
            asm volatile("s_waitcnt vmcnt(0)" ::: "memory");
            const unsigned og = xb_add(&bar[XB_TOP], 1u);
            const unsigned tg = og / nx;
            if (og + 1u == (tg + 1u) * nx) xb_add(&bar[XB_TOPGEN], 1u);
            else XB_SPIN(xb_ld(&bar[XB_TOPGEN]) == tg, bar);
            __builtin_amdgcn_fence(__ATOMIC_ACQUIRE, "agent");
            xb_add(&bar[XB_XGEN(b.x)], 1u);
            asm volatile("s_waitcnt vmcnt(0)" ::: "memory");
        } else {
            XB_SPIN(xb_ld(&bar[XB_XGEN(b.x)]) == gen, bar);
            __builtin_amdgcn_fence(__ATOMIC_ACQUIRE, "agent");
            asm volatile("s_waitcnt vmcnt(0)" ::: "memory");
        }
    }
    __syncthreads();
}

__device__ __forceinline__ float bf2f(bf16 b) { return __uint_as_float(((unsigned)b) << 16); }
__device__ __forceinline__ float wave_sum(float v) {
#pragma unroll
    for (int o = 1; o < 64; o <<= 1) v += __shfl_xor(v, o);
    return v;
}
__device__ __forceinline__ float fexp(float x) { return __builtin_amdgcn_exp2f(x * 1.4426950408889634f); }
__device__ __forceinline__ float flog(float x) { return __builtin_amdgcn_logf(x) * 0.6931471805599453f; }
__device__ __forceinline__ float frcp(float x) { return __builtin_amdgcn_rcpf(x); }
__device__ __forceinline__ float fsqrt(float x) { return __builtin_amdgcn_sqrtf(x); }
__device__ __forceinline__ float frsq(float x) { return __builtin_amdgcn_rsqf(x); }
__device__ __forceinline__ float sigmoid_f(float x) { return frcp(1.0f + fexp(-x)); }
__device__ __forceinline__ float silu_x(float x) { return x * frcp(1.0f + fexp(-x)); }
__device__ __forceinline__ float softplus_f(float x) { return fmaxf(x, 0.0f) + flog(1.0f + fexp(-fabsf(x))); }
__device__ __forceinline__ float logsigmoid_f(float x) { return fminf(x, 0.0f) - flog(1.0f + fexp(-fabsf(x))); }
__device__ __forceinline__ float tanh_f(float x) { const float e = fexp(-2.0f * fabsf(x)); const float t = (1.0f - e) * frcp(1.0f + e); return x < 0.f ? -t : t; }
__device__ __forceinline__ float gelu_tanh_f(float x) { const float u = 0.7978845608028654f * (x + 0.044715f * x * x * x); return 0.5f * x * (1.0f + tanh_f(u)); }

__device__ __forceinline__ void tr_item(const float* W, size_t ldw, int scol0, int nvalid, bf16* WT, int K, int drow0, int k0, LAS float* scr, int lane) {
    const int j = lane & 31;
#pragma unroll 8
    for (int i = 0; i < 32; ++i) { const int kk = 2 * i + (lane >> 5); scr[kk * 33 + j] = (j < nvalid) ? W[(size_t)(k0 + kk) * ldw + scol0 + j] : 0.0f; }
    LDS_WAIT(); asm volatile("" ::: "memory");
    const int c = lane & 7;
#pragma unroll
    for (int jj = 0; jj < 4; ++jj) { const int n = (lane >> 3) + 8 * jj; const LAS float* s = scr + (8 * c) * 33 + n;
        v4u o; o.x = pk2(s[0 * 33], s[1 * 33]); o.y = pk2(s[2 * 33], s[3 * 33]); o.z = pk2(s[4 * 33], s[5 * 33]); o.w = pk2(s[6 * 33], s[7 * 33]);
        *(GAS v4u*)(WT + (size_t)(drow0 + n) * K + k0 + 8 * c) = o; }
    LDS_WAIT(); asm volatile("" ::: "memory");
}
constexpr int IT_EIN = (N_EIN / 32) * (D / 64), IT_EOUT = (D / 32) * (D / 64), IT_F13 = (N_F13 / 32) * (D / 64), IT_F2 = (D / 32) * (FF / 64), IT_OIN = (N_OIN / 32) * (D / 64), IT_OOUT = (D / 32) * (K_OOUT / 64);
constexpr int IT_LORA = 16 + 16 + 32;
constexpr int IT_SMALL = IT_EIN + IT_EOUT + IT_F13 + IT_F2 + IT_OIN + IT_OOUT + IT_LORA;
constexpr int IT_E13 = (NE * N_E13 / 32) * (D / 64), IT_E2 = (NE * D / 32) * (FE / 64), IT_EXP = IT_E13 + IT_E2;

__device__ __forceinline__ void cvt_small_item(const float* const* in, unsigned char* ws, int it, LAS float* scr, int lane) {
    int r = it;
    if (r < IT_EIN) { const int db = r / (D / 64), kb = r % (D / 64), r0 = 32 * db;
        if (r0 >= E_GK && r0 < E_XB) return;
        const int sc = r0 < E_GK ? r0 : r0 - 240;
        tr_item(in[1], 2576, sc, 32, (bf16*)(ws + WS_WEIN), D, r0, 64 * kb, scr, lane); return; } r -= IT_EIN;
    if (r < IT_EOUT) { const int db = r / (D / 64), kb = r % (D / 64); tr_item(in[12], D, 32 * db, 32, (bf16*)(ws + WS_WEOUT), D, 32 * db, 64 * kb, scr, lane); return; } r -= IT_EOUT;
    if (r < IT_F13) { const int db = r / (D / 64), kb = r % (D / 64), r0 = 32 * db, tile = r0 >> 8, within = r0 & 255;
        tr_item(within < 128 ? in[15] : in[16], FF, tile * 128 + (within & 127), 32, (bf16*)(ws + WS_WF13), D, r0, 64 * kb, scr, lane); return; } r -= IT_F13;
    if (r < IT_F2) { const int db = r / (FF / 64), kb = r % (FF / 64); tr_item(in[17], D, 32 * db, 32, (bf16*)(ws + WS_WF2), FF, 32 * db, 64 * kb, scr, lane); return; } r -= IT_F2;
    if (r < IT_OIN) { const int db = r / (D / 64), kb = r % (D / 64), r0 = 32 * db;
        int sc, nv; if (r0 < O_R) { sc = r0; nv = 32; } else if (r0 < O_DT) { sc = r0 + 16; nv = 32; } else if (r0 == O_DT) { sc = 2560; nv = 16; } else { sc = 0; nv = 0; }
        tr_item(in[20], 4368, sc, nv, (bf16*)(ws + WS_WOIN), D, r0, 64 * kb, scr, lane); return; } r -= IT_OIN;
    if (r < IT_OOUT) { const int db = r / (K_OOUT / 64), kb = r % (K_OOUT / 64); tr_item(in[38], D, 32 * db, 32, (bf16*)(ws + WS_WOOUT), K_OOUT, 32 * db, 64 * kb, scr, lane); return; } r -= IT_OOUT;
    if (r < 16) { tr_item(in[29], 512, 32 * r, 32, (bf16*)(ws + WS_LW2), 64, 32 * r, 0, scr, lane); return; } r -= 16;
    if (r < 16) { tr_item(in[31], 512, 32 * r, 32, (bf16*)(ws + WS_LA2), 64, 32 * r, 0, scr, lane); return; } r -= 16;
    { const int db = r >> 1, kb = r & 1; tr_item(in[32], 512, 32 * db, 32, (bf16*)(ws + WS_LG2), 128, 32 * db, 64 * kb, scr, lane); }
}
__device__ __forceinline__ void cvt_exp_item(const float* const* in, unsigned char* ws, int it, LAS float* scr, int lane) {
    int r = it;
    if (r < IT_E13) { const int db = r / (D / 64), kb = r % (D / 64), r0 = 32 * db, e = r0 / N_E13, rr = r0 - e * N_E13, tile = rr >> 8, within = rr & 255;
        const float* W = (within < 128 ? in[42] : in[43]) + (size_t)e * D * FE;
        tr_item(W, FE, tile * 128 + (within & 127), 32, (bf16*)(ws + WS_EXP13), D, r0, 64 * kb, scr, lane); return; } r -= IT_E13;
    { const int db = r / (FE / 64), kb = r % (FE / 64), r0 = 32 * db, e = r0 / D;
        tr_item(in[44] + (size_t)e * FE * D, D, r0 - e * D, 32, (bf16*)(ws + WS_EXP2), FE, r0, 64 * kb, scr, lane); }
}

template <int MODE>
__device__ __forceinline__ void ln_rows(const float* xin, const float* y, const float* gam, const float* bet, float* outf, bf16* outb,
                                        const float* router, unsigned char* ws, gu32* ctl, int gw, int NGW, int lane) {
    for (int m = gw; m < M; m += NGW) {
        const GAS f32x4* xr = (const GAS f32x4*)(xin + (size_t)m * D) + lane;
        f32x4 v[4];
        if (MODE == 2) {
            const int* rdst = (const int*)(ws + WS_ROUTE + RT_DST) + 2 * m; const float* rw = (const float*)(ws + WS_ROUTE + RT_W) + 2 * m;
            const int d0 = rdst[0], d1 = rdst[1]; const float w0 = rw[0], w1 = rw[1];
            const GAS v2u* y0 = (const GAS v2u*)((const bf16*)(ws + WS_XY) + (size_t)d0 * D) + lane; const GAS v2u* y1 = (const GAS v2u*)((const bf16*)(ws + WS_XY) + (size_t)d1 * D) + lane;
#pragma unroll
            for (int j = 0; j < 4; ++j) { const v2u a = y0[64 * j], b = y1[64 * j]; const f32x4 xv = xr[64 * j];
                v[j].x = ALPHA * xv.x + w0 * __uint_as_float(a.x << 16) + w1 * __uint_as_float(b.x << 16);
                v[j].y = ALPHA * xv.y + w0 * __uint_as_float(a.x & 0xffff0000u) + w1 * __uint_as_float(b.x & 0xffff0000u);
                v[j].z = ALPHA * xv.z + w0 * __uint_as_float(a.y << 16) + w1 * __uint_as_float(b.y << 16);
                v[j].w = ALPHA * xv.w + w0 * __uint_as_float(a.y & 0xffff0000u) + w1 * __uint_as_float(b.y & 0xffff0000u); }
        } else {
            const GAS f32x4* yr = (const GAS f32x4*)(y + (size_t)m * D) + lane;
#pragma unroll
            for (int j = 0; j < 4; ++j) { const f32x4 xv = xr[64 * j], yv = yr[64 * j]; v[j] = xv * ALPHA + yv; }
        }
        float s = 0.f;
#pragma unroll
        for (int j = 0; j < 4; ++j) s += (v[j].x + v[j].y) + (v[j].z + v[j].w);
        const float mean = wave_sum(s) * (1.f / D); float s2 = 0.f;
#pragma unroll
        for (int j = 0; j < 4; ++j) { v[j] = v[j] - mean; s2 += (v[j].x * v[j].x + v[j].y * v[j].y) + (v[j].z * v[j].z + v[j].w * v[j].w); }
        const float rstd = 1.f / sqrtf(wave_sum(s2) * (1.f / D) + LN_EPS);
        GAS f32x4* of = (GAS f32x4*)(outf + (size_t)m * D) + lane;
#pragma unroll
        for (int j = 0; j < 4; ++j) { const f32x4 gv = ((const GAS f32x4*)gam)[lane + 64 * j], bv = ((const GAS f32x4*)bet)[lane + 64 * j]; v[j] = v[j] * rstd * gv + bv; of[64 * j] = v[j]; }
        if (MODE != 2) { GAS v2u* ob = (GAS v2u*)(outb + (size_t)m * D) + lane;
#pragma unroll
            for (int j = 0; j < 4; ++j) { v2u o; o.x = pk2(v[j].x, v[j].y); o.y = pk2(v[j].z, v[j].w); ob[64 * j] = o; } }
        if (MODE == 1) {
            float lg[8];
#pragma unroll
            for (int e = 0; e < 8; ++e) lg[e] = 0.f;
#pragma unroll
            for (int j = 0; j < 4; ++j) {
#pragma unroll
                for (int i = 0; i < 4; ++i) { const int c = 4 * lane + 256 * j + i; const f32x4 r0 = ((const GAS f32x4*)router)[2 * c], r1 = ((const GAS f32x4*)router)[2 * c + 1]; const float xv = v[j][i];
                    lg[0] += xv * r0.x; lg[1] += xv * r0.y; lg[2] += xv * r0.z; lg[3] += xv * r0.w; lg[4] += xv * r1.x; lg[5] += xv * r1.y; lg[6] += xv * r1.z; lg[7] += xv * r1.w; } }
#pragma unroll
            for (int e = 0; e < 8; ++e) lg[e] = wave_sum(lg[e]);
            int i0 = 0; float v0 = lg[0];
#pragma unroll
            for (int e = 1; e < 8; ++e) if (lg[e] > v0) { v0 = lg[e]; i0 = e; }
            int i1 = -1; float v1 = -INFINITY;
#pragma unroll
            for (int e = 0; e < 8; ++e) if (e != i0 && lg[e] > v1) { v1 = lg[e]; i1 = e; }
            const float w0 = 1.0f / (1.0f + expf(v1 - v0)), w1 = 1.0f - w0;
            if (lane == 0) {
                const unsigned p0 = __hip_atomic_fetch_add(ctl + CW_CNT + 64 * i0, 1u, RLX_AGENT), p1 = __hip_atomic_fetch_add(ctl + CW_CNT + 64 * i1, 1u, RLX_AGENT);
                int* re = (int*)(ws + WS_ROUTE + RT_E) + 2 * m; int* rp = (int*)(ws + WS_ROUTE + RT_P) + 2 * m; float* rw = (float*)(ws + WS_ROUTE + RT_W) + 2 * m;
                re[0] = i0; re[1] = i1; rp[0] = (int)p0; rp[1] = (int)p1; rw[0] = w0; rw[1] = w1; }
        }
    }
}

__device__ __forceinline__ void ssd_norm_rows(const float* const* in, unsigned char* ws, int gw, int NGW, int lane) {
    const bf16* P = (const bf16*)(ws + WS_P); const bf16* ssdy = (const bf16*)(ws + WS_SSDY); bf16* mix = (bf16*)(ws + WS_MIX1); const float* nw = in[26];
    for (int m = gw; m < M; m += NGW) {
        float yv[16]; float ss = 0.f;
#pragma unroll
        for (int q = 0; q < 4; ++q) { const v2u yb2 = *(const GAS v2u*)(ssdy + (size_t)m * D + 16 * lane + 4 * q); const f32x4 y4 = (f32x4){__uint_as_float(yb2.x << 16), __uint_as_float(yb2.x & 0xffff0000u), __uint_as_float(yb2.y << 16), __uint_as_float(yb2.y & 0xffff0000u)}; const v2u z2 = *(const GAS v2u*)(P + (size_t)m * N_OIN + O_Z + 16 * lane + 4 * q);
            const float z0 = __uint_as_float(z2.x << 16), z1 = __uint_as_float(z2.x & 0xffff0000u), z2f = __uint_as_float(z2.y << 16), z3 = __uint_as_float(z2.y & 0xffff0000u);
            yv[4 * q] = y4.x * silu_x(z0); yv[4 * q + 1] = y4.y * silu_x(z1); yv[4 * q + 2] = y4.z * silu_x(z2f); yv[4 * q + 3] = y4.w * silu_x(z3); }
#pragma unroll
        for (int i = 0; i < 16; ++i) ss += yv[i] * yv[i];
#pragma unroll
        for (int o = 1; o < 32; o <<= 1) ss += __shfl_xor(ss, o);
        const float rs = frsq(ss * (1.0f / 512.0f) + 1e-5f);
        v4u o0, o1;
        o0.x = pk2(yv[0] * rs * nw[16 * lane + 0], yv[1] * rs * nw[16 * lane + 1]); o0.y = pk2(yv[2] * rs * nw[16 * lane + 2], yv[3] * rs * nw[16 * lane + 3]);
        o0.z = pk2(yv[4] * rs * nw[16 * lane + 4], yv[5] * rs * nw[16 * lane + 5]); o0.w = pk2(yv[6] * rs * nw[16 * lane + 6], yv[7] * rs * nw[16 * lane + 7]);
        o1.x = pk2(yv[8] * rs * nw[16 * lane + 8], yv[9] * rs * nw[16 * lane + 9]); o1.y = pk2(yv[10] * rs * nw[16 * lane + 10], yv[11] * rs * nw[16 * lane + 11]);
        o1.z = pk2(yv[12] * rs * nw[16 * lane + 12], yv[13] * rs * nw[16 * lane + 13]); o1.w = pk2(yv[14] * rs * nw[16 * lane + 14], yv[15] * rs * nw[16 * lane + 15]);
        GAS v4u* mo = (GAS v4u*)(mix + (size_t)m * K_OOUT + 16 * lane); mo[0] = o0; mo[1] = o1;
    }
}
__device__ __forceinline__ void rwkv_pre_tile(const float* const* in, unsigned char* ws, LAS float* L, int tile, int tid) {
    asm volatile("" : "+v"(tid));
    const bf16* P = (const bf16*)(ws + WS_P); const float* mu = in[27];
    float* DEC = (float*)(ws + WS_DEC); float* AA = (float*)(ws + WS_AA); bf16* GG = (bf16*)(ws + WS_GG);
    LAS float* tw = L; LAS float* xa = tw + 32 * 64; LAS float* sg = xa + 32 * 64;
    const int m0 = tile * 32;
    for (int idx = tid; idx < 32 * 256; idx += 512) { const int t = idx >> 8, c = idx & 255, m = m0 + t;
        const float cur = bf2f(P[(size_t)m * N_OIN + O_R + 1536 + c]); const float prev = (m % T) ? bf2f(P[(size_t)(m - 1) * N_OIN + O_R + 1536 + c]) : 0.f;
        const float pm = cur + (prev - cur) * mu[1536 + c];
        if (c < 64) tw[t * 64 + c] = tanh_f(pm); else if (c < 128) xa[t * 64 + (c - 64)] = pm; else sg[t * 128 + (c - 128)] = sigmoid_f(pm); }
    __syncthreads();
    const int j = tid; float acc[32];
#pragma unroll
    for (int t = 0; t < 32; ++t) acc[t] = 0.f;
    for (int i = 0; i < 64; i += 4) { const float w0 = in[29][(i) * 512 + j], w1 = in[29][(i + 1) * 512 + j], w2 = in[29][(i + 2) * 512 + j], w3 = in[29][(i + 3) * 512 + j];
#pragma unroll
        for (int t = 0; t < 32; ++t) { const f32x4 x = *(const LAS f32x4*)(tw + t * 64 + i); acc[t] += x.x * w0 + x.y * w1 + x.z * w2 + x.w * w3; } }
    { const float w0j = in[28][j];
#pragma unroll
      for (int t = 0; t < 32; ++t) { const float wl = -softplus_f(-(w0j + acc[t])) - 0.5f; DEC[(size_t)(m0 + t) * 512 + j] = fexp(-fexp(wl)); } }
#pragma unroll
    for (int t = 0; t < 32; ++t) acc[t] = 0.f;
    for (int i = 0; i < 64; i += 4) { const float w0 = in[31][(i) * 512 + j], w1 = in[31][(i + 1) * 512 + j], w2 = in[31][(i + 2) * 512 + j], w3 = in[31][(i + 3) * 512 + j];
#pragma unroll
        for (int t = 0; t < 32; ++t) { const f32x4 x = *(const LAS f32x4*)(xa + t * 64 + i); acc[t] += x.x * w0 + x.y * w1 + x.z * w2 + x.w * w3; } }
    { const float a0j = in[30][j];
#pragma unroll
      for (int t = 0; t < 32; ++t) AA[(size_t)(m0 + t) * 512 + j] = sigmoid_f(a0j + acc[t]); }
#pragma unroll
    for (int t = 0; t < 32; ++t) acc[t] = 0.f;
    for (int i = 0; i < 128; i += 4) { const float w0 = in[32][(i) * 512 + j], w1 = in[32][(i + 1) * 512 + j], w2 = in[32][(i + 2) * 512 + j], w3 = in[32][(i + 3) * 512 + j];
#pragma unroll
        for (int t = 0; t < 32; ++t) { const f32x4 x = *(const LAS f32x4*)(sg + t * 128 + i); acc[t] += x.x * w0 + x.y * w1 + x.z * w2 + x.w * w3; } }
#pragma unroll
    for (int t = 0; t < 32; ++t) GG[(size_t)(m0 + t) * 512 + j] = (bf16)f2bf(acc[t]);
    __syncthreads();
}

typedef short bf16x8_t __attribute__((ext_vector_type(8)));
typedef float f32x16 __attribute__((ext_vector_type(16)));
template <int K>
__device__ __forceinline__ void mm32(f32x16& acc, const LAS bf16* A, int pa, int arow0, const LAS bf16* Bt, int pb, int brow0, int lane) {
    const LAS bf16* ap = A + (arow0 + (lane & 31)) * pa + 8 * (lane >> 5); const LAS bf16* bp = Bt + (brow0 + (lane & 31)) * pb + 8 * (lane >> 5);
#pragma unroll
    for (int ks = 0; ks < K / 16; ++ks) { const bf16x8_t a = *(const LAS bf16x8_t*)(ap + 16 * ks); const bf16x8_t b = *(const LAS bf16x8_t*)(bp + 16 * ks);
        acc = __builtin_amdgcn_mfma_f32_32x32x16_bf16(a, b, acc, 0, 0, 0); }
}
__device__ __forceinline__ int accrow(int r, int lane) { return (r & 3) + 8 * (r >> 2) + 4 * (lane >> 5); }

namespace gl {
constexpr int PQ = 72, POB = 132;
constexpr size_t G_QT = 38 * MiB, G_KT = 46 * MiB, G_KDT = 54 * MiB, G_VT = 62 * MiB, G_ST = 78 * MiB, G_DEC = 94 * MiB;
constexpr int L_RQ = 0, L_RK = 8192, L_RGK = 16384, L_RV = 24576, L_SEG = 40960, L_PRE_END = 43008;
constexpr int M_KD = 0, M_VT = 9216, M_DEC = 27648, M_BUF = 27904;
constexpr int L_OB = 0, L_RG = 33792, L_QT = 50176, L_KT = L_QT + 9216, L_VT = L_KT + 9216, L_AT = L_VT + 18432, L_ST = L_AT + 9216, L_POST_END = L_ST + 18432;
static_assert(L_POST_END <= LDS_BYTES - 2048, "gla LDS");
}
__device__ __forceinline__ void gla_pre_unit(const float* const* in, unsigned char* ws, LAS unsigned char* lds, int u, int tid) {
    asm volatile("" : "+v"(tid));
    using namespace gl;
    const int c = u & 31, h = (u >> 5) & 3, b = u >> 7;
    const bf16* P = (const bf16*)(ws + WS_P);
    LAS bf16* RQ = (LAS bf16*)(lds + L_RQ); LAS bf16* RK = (LAS bf16*)(lds + L_RK); LAS bf16* RGK = (LAS bf16*)(lds + L_RGK); LAS bf16* RV = (LAS bf16*)(lds + L_RV); LAS float* SEG = (LAS float*)(lds + L_SEG);
    bf16* QTg = (bf16*)(ws + G_QT) + (size_t)u * 4096; bf16* KTg = (bf16*)(ws + G_KT) + (size_t)u * 4096; bf16* KDg = (bf16*)(ws + G_KDT) + (size_t)u * 4096; bf16* VTg = (bf16*)(ws + G_VT) + (size_t)u * 8192; float* DECg = (float*)(ws + G_DEC) + (size_t)u * 64;
    const int lt = tid >> 3, lc = tid & 7;
    const size_t row0 = (size_t)b * T + c * 64;
    { const bf16* pr = P + (row0 + lt) * N_EIN + h * 64 + 8 * lc;
      *(LAS v4u*)(RQ + lt * 64 + 8 * lc) = *(const GAS v4u*)(pr + E_Q); *(LAS v4u*)(RK + lt * 64 + 8 * lc) = *(const GAS v4u*)(pr + E_K); *(LAS v4u*)(RGK + lt * 64 + 8 * lc) = *(const GAS v4u*)(pr + E_GK);
      const bf16* p0 = P + (row0 + (tid >> 4)) * N_EIN + h * 128 + 8 * (tid & 15); const bf16* p1 = p0 + (size_t)32 * N_EIN;
      *(LAS v4u*)(RV + (tid >> 4) * 128 + 8 * (tid & 15)) = *(const GAS v4u*)(p0 + E_V); *(LAS v4u*)(RV + (32 + (tid >> 4)) * 128 + 8 * (tid & 15)) = *(const GAS v4u*)(p1 + E_V); }
    __syncthreads();
    const int ed = tid & 63, eseg = tid >> 6, ev = tid & 127, evs = tid >> 7;
    const float gkb = in[3][h * 64 + ed];
    float cs[8];
    { float run = 0.f;
#pragma unroll
      for (int i = 0; i < 8; ++i) { const float gkv = bf2f(RGK[(8 * eseg + i) * 64 + ed]) + gkb; run += logsigmoid_f(gkv) * (1.0f / 16.0f); cs[i] = run; }
      SEG[eseg * 64 + ed] = run; }
    __syncthreads();
    { float prefix = 0.f, total = 0.f;
#pragma unroll
      for (int s = 0; s < 8; ++s) { const float v = SEG[s * 64 + ed]; total += v; prefix += (s < eseg) ? v : 0.f; }
      unsigned kd[4];
#pragma unroll
      for (int i = 0; i < 8; i += 2) { const int ta = 8 * eseg + i; const float b0 = prefix + cs[i], b1 = prefix + cs[i + 1];
          const float q0 = bf2f(RQ[ta * 64 + ed]), q1 = bf2f(RQ[(ta + 1) * 64 + ed]), k0 = bf2f(RK[ta * 64 + ed]), k1 = bf2f(RK[(ta + 1) * 64 + ed]);
          QTg[ta * 64 + ed] = (bf16)f2bf(q0 * 0.125f * fexp(b0)); QTg[(ta + 1) * 64 + ed] = (bf16)f2bf(q1 * 0.125f * fexp(b1));
          KTg[ta * 64 + ed] = (bf16)f2bf(k0 * fexp(-b0)); KTg[(ta + 1) * 64 + ed] = (bf16)f2bf(k1 * fexp(-b1));
          kd[i >> 1] = pk2(k0 * fexp(total - b0), k1 * fexp(total - b1)); }
      *(GAS v4u*)(KDg + ed * 64 + 8 * eseg) = (v4u){kd[0], kd[1], kd[2], kd[3]};
      if (eseg == 0) DECg[ed] = fexp(total);
      unsigned vv[8];
#pragma unroll
      for (int i = 0; i < 16; i += 2) vv[i >> 1] = (unsigned)RV[(16 * evs + i) * 128 + ev] | ((unsigned)RV[(16 * evs + i + 1) * 128 + ev] << 16);
      *(GAS v4u*)(VTg + ev * 64 + 16 * evs) = (v4u){vv[0], vv[1], vv[2], vv[3]}; *(GAS v4u*)(VTg + ev * 64 + 16 * evs + 8) = (v4u){vv[4], vv[5], vv[6], vv[7]}; }
    __syncthreads();
}
__device__ __forceinline__ void gla_mid_item(unsigned char* ws, LAS unsigned char* lds, int item, int tid) {
    asm volatile("" : "+v"(tid));
    using namespace gl;
    const int lane = tid & 63, wave = tid >> 6, db = wave >> 2, vb = wave & 3;
    const bf16* KDg = (const bf16*)(ws + G_KDT) + (size_t)item * 32 * 4096; const bf16* VTg = (const bf16*)(ws + G_VT) + (size_t)item * 32 * 8192; const float* DECg = (const float*)(ws + G_DEC) + (size_t)item * 32 * 64;
    bf16* STg = (bf16*)(ws + G_ST) + (size_t)item * 32 * 8192;
    f32x16 S;
#pragma unroll
    for (int r = 0; r < 16; ++r) S[r] = 0.f;
    v4u rk, rv0, rv1; float rd = 0.f;
#define GLM_LOAD(c_) do { rk = *(const GAS v4u*)(KDg + (size_t)(c_) * 4096 + 8 * tid); rv0 = *(const GAS v4u*)(VTg + (size_t)(c_) * 8192 + 8 * tid); rv1 = *(const GAS v4u*)(VTg + (size_t)(c_) * 8192 + 4096 + 8 * tid); \
        if (tid < 64) rd = DECg[(c_) * 64 + tid]; } while (0)
    GLM_LOAD(0);
    for (int c = 0; c < 32; ++c) {
        LAS unsigned char* B = lds + (c & 1) * M_BUF;
        LAS bf16* KD = (LAS bf16*)(B + M_KD); LAS bf16* VT = (LAS bf16*)(B + M_VT); LAS float* DEC = (LAS float*)(B + M_DEC);
        *(LAS v4u*)(KD + (tid >> 3) * PQ + 8 * (tid & 7)) = rk; *(LAS v4u*)(VT + (tid >> 3) * PQ + 8 * (tid & 7)) = rv0; *(LAS v4u*)(VT + (64 + (tid >> 3)) * PQ + 8 * (tid & 7)) = rv1;
        if (tid < 64) DEC[tid] = rd;
        if (c + 1 < 32) GLM_LOAD(c + 1);
#pragma unroll
        for (int g4 = 0; g4 < 4; ++g4) { v2u w; w.x = pk2(S[4 * g4], S[4 * g4 + 1]); w.y = pk2(S[4 * g4 + 2], S[4 * g4 + 3]);
            *(GAS v2u*)(STg + (size_t)c * 8192 + (32 * vb + (lane & 31)) * 64 + 32 * db + 8 * g4 + 4 * (lane >> 5)) = w; }
        __syncthreads();
#pragma unroll
        for (int g4 = 0; g4 < 4; ++g4) { const f32x4 dv = *(const LAS f32x4*)(DEC + 32 * db + 8 * g4 + 4 * (lane >> 5));
            S[4 * g4] *= dv.x; S[4 * g4 + 1] *= dv.y; S[4 * g4 + 2] *= dv.z; S[4 * g4 + 3] *= dv.w; }
        mm32<64>(S, KD, PQ, 32 * db, VT, PQ, 32 * vb, lane);
    }
    __syncthreads();
#undef GLM_LOAD
}
__device__ __forceinline__ void gla_post_unit(const float* const* in, unsigned char* ws, LAS unsigned char* lds, int u, int tid) {
    asm volatile("" : "+v"(tid));
    using namespace gl;
    const int c = u & 31, h = (u >> 5) & 3, b = u >> 7, lane = tid & 63, wave = tid >> 6;
    const bf16* P = (const bf16*)(ws + WS_P); bf16* mix = (bf16*)(ws + WS_MIX0); const float* gnorm = in[4];
    const bf16* QTg = (const bf16*)(ws + G_QT) + (size_t)u * 4096; const bf16* KTg = (const bf16*)(ws + G_KT) + (size_t)u * 4096; const bf16* VTg = (const bf16*)(ws + G_VT) + (size_t)u * 8192; const bf16* STg = (const bf16*)(ws + G_ST) + (size_t)u * 8192;
    LAS float* OB = (LAS float*)(lds + L_OB); LAS bf16* RG = (LAS bf16*)(lds + L_RG);
    LAS bf16* QT = (LAS bf16*)(lds + L_QT); LAS bf16* KT = (LAS bf16*)(lds + L_KT); LAS bf16* VT = (LAS bf16*)(lds + L_VT); LAS bf16* AT = (LAS bf16*)(lds + L_AT); LAS bf16* ST = (LAS bf16*)(lds + L_ST);
    const size_t row0 = (size_t)b * T + c * 64;
    { const int r8 = tid >> 3, c8 = tid & 7;
      *(LAS v4u*)(QT + r8 * PQ + 8 * c8) = *(const GAS v4u*)(QTg + 8 * tid); *(LAS v4u*)(KT + r8 * PQ + 8 * c8) = *(const GAS v4u*)(KTg + 8 * tid);
      *(LAS v4u*)(VT + r8 * PQ + 8 * c8) = *(const GAS v4u*)(VTg + 8 * tid); *(LAS v4u*)(VT + (64 + r8) * PQ + 8 * c8) = *(const GAS v4u*)(VTg + 4096 + 8 * tid);
      *(LAS v4u*)(ST + r8 * PQ + 8 * c8) = *(const GAS v4u*)(STg + 8 * tid); *(LAS v4u*)(ST + (64 + r8) * PQ + 8 * c8) = *(const GAS v4u*)(STg + 4096 + 8 * tid);
      const bf16* p0 = P + (row0 + (tid >> 4)) * N_EIN + E_G + h * 128 + 8 * (tid & 15); const bf16* p1 = p0 + (size_t)32 * N_EIN;
      *(LAS v4u*)(RG + (tid >> 4) * 128 + 8 * (tid & 15)) = *(const GAS v4u*)(p0); *(LAS v4u*)(RG + (32 + (tid >> 4)) * 128 + 8 * (tid & 15)) = *(const GAS v4u*)(p1); }
    __syncthreads();
    const int tb = wave >> 2, vb = wave & 3;
    f32x16 o;
#pragma unroll
    for (int r = 0; r < 16; ++r) o[r] = 0.f;
    mm32<64>(o, QT, PQ, 32 * tb, ST, PQ, 32 * vb, lane);
    if (wave < 4) { const int tb2 = wave >> 1, sb = wave & 1; f32x16 a;
#pragma unroll
        for (int r = 0; r < 16; ++r) a[r] = 0.f;
        if (sb <= tb2) mm32<64>(a, QT, PQ, 32 * tb2, KT, PQ, 32 * sb, lane);
#pragma unroll
        for (int r = 0; r < 16; ++r) { const int tt = 32 * tb2 + accrow(r, lane), ss = 32 * sb + (lane & 31); AT[tt * PQ + ss] = (bf16)f2bf(ss <= tt ? a[r] : 0.f); } }
    __syncthreads();
    mm32<64>(o, AT, PQ, 32 * tb, VT, PQ, 32 * vb, lane);
#pragma unroll
    for (int r = 0; r < 16; ++r) OB[(32 * tb + accrow(r, lane)) * POB + 32 * vb + (lane & 31)] = o[r];
    __syncthreads();
    { const int t = tid >> 3, vs = tid & 7; float ov[16]; float ss = 0.f;
#pragma unroll
      for (int q = 0; q < 4; ++q) { const f32x4 x = *(const LAS f32x4*)(OB + t * POB + 16 * vs + 4 * q); ov[4 * q] = x.x; ov[4 * q + 1] = x.y; ov[4 * q + 2] = x.z; ov[4 * q + 3] = x.w; ss += (x.x * x.x + x.y * x.y) + (x.z * x.z + x.w * x.w); }
      ss += __shfl_xor(ss, 1); ss += __shfl_xor(ss, 2); ss += __shfl_xor(ss, 4);
      const float rs = frsq(ss * (1.0f / 128.0f) + 1e-5f);
      unsigned ow[8];
#pragma unroll
      for (int i = 0; i < 16; i += 2) { const float g0 = bf2f(RG[t * 128 + 16 * vs + i]), g1 = bf2f(RG[t * 128 + 16 * vs + i + 1]);
          ow[i >> 1] = pk2(ov[i] * rs * gnorm[16 * vs + i] * silu_x(g0), ov[i + 1] * rs * gnorm[16 * vs + i + 1] * silu_x(g1)); }
      GAS v4u* mo = (GAS v4u*)(mix + (row0 + t) * D + h * 128 + 16 * vs); mo[0] = (v4u){ow[0], ow[1], ow[2], ow[3]}; mo[1] = (v4u){ow[4], ow[5], ow[6], ow[7]}; }
    __syncthreads();
}
namespace lr {
constexpr int PQ = 72;
constexpr size_t G_HL = 96 * MiB, G_CP = 128 * MiB, G_TOT = 160 * MiB;
constexpr int L_XBW = 0, L_XC = L_XBW + 67 * 64 * 4, L_XCB = L_XC + 16384, L_WA = L_XCB + 9216, L_WX = L_WA + 9216, L_PR = L_WX + 9216, L_SEG = L_PR + 32768, L_END = L_SEG + 4096;
static_assert(L_END <= LDS_BYTES - 2048, "lru LDS");
}
__device__ __forceinline__ void lru_pre_unit(const float* const* in, unsigned char* ws, LAS unsigned char* lds, int u, int tid, bool setup) {
    asm volatile("" : "+v"(tid));
    using namespace lr;
    const int c = u & 31, n = (u >> 5) & 7, b = u >> 8, lane = tid & 63, wave = tid >> 6;
    const bf16* P = (const bf16*)(ws + WS_P);
    const float* conv_w = in[5]; const float* conv_b = in[6]; const float* wa = in[7] + n * 4096; const float* ba = in[8]; const float* wx = in[9] + n * 4096; const float* bx = in[10]; const float* lam = in[11];
    LAS float* xbw = (LAS float*)(lds + L_XBW); LAS float* xc = (LAS float*)(lds + L_XC); LAS bf16* XCB = (LAS bf16*)(lds + L_XCB); LAS bf16* WA = (LAS bf16*)(lds + L_WA); LAS bf16* WX = (LAS bf16*)(lds + L_WX);
    LAS float* PR = (LAS float*)(lds + L_PR); LAS float* SEG = (LAS float*)(lds + L_SEG);
    float* HL = (float*)(ws + G_HL) + (size_t)u * 4096; float* CP = (float*)(ws + G_CP) + (size_t)u * 4096; float* TOT = (float*)(ws + G_TOT) + (size_t)u * 128;
    if (setup) for (int idx = tid; idx < 4096; idx += 512) { const int k = idx >> 6, cc = idx & 63; WA[cc * PQ + k] = (bf16)f2bf(wa[idx]); WX[cc * PQ + k] = (bf16)f2bf(wx[idx]); }
    const int cch = tid & 63, tq = tid >> 6, ch = n * 64 + cch, t0 = c * 64;
    const float cw0 = conv_w[ch], cw1 = conv_w[512 + ch], cw2 = conv_w[1024 + ch], cw3 = conv_w[1536 + ch], cb = conv_b[ch];
    const float bac = ba[ch], bxc = bx[ch], spl = softplus_f(-lam[ch]);
    const int mat = wave >> 2, tb = (wave >> 1) & 1, cbk = wave & 1;
    for (int idx = tid; idx < 67 * 64; idx += 512) { const int r = idx >> 6, cc = idx & 63, tt = t0 - 3 + r;
        xbw[idx] = tt >= 0 ? bf2f(P[(size_t)(b * T + tt) * N_EIN + E_XB + n * 64 + cc]) : 0.f; }
    __syncthreads();
    float xv[8];
#pragma unroll
    for (int i = 0; i < 8; ++i) { const int t = tq * 8 + i; const float v = cb + cw0 * xbw[t * 64 + cch] + cw1 * xbw[(t + 1) * 64 + cch] + cw2 * xbw[(t + 2) * 64 + cch] + cw3 * xbw[(t + 3) * 64 + cch];
        xv[i] = v; XCB[t * PQ + cch] = (bf16)f2bf(v); }
    __syncthreads();
    { f32x16 acc;
#pragma unroll
      for (int r = 0; r < 16; ++r) acc[r] = 0.f;
      mm32<64>(acc, XCB, PQ, 32 * tb, mat ? WX : WA, PQ, 32 * cbk, lane);
#pragma unroll
      for (int r = 0; r < 16; ++r) PR[mat * 4096 + (32 * tb + accrow(r, lane)) * 64 + 32 * cbk + (lane & 31)] = acc[r]; }
    __syncthreads();
    float hl[8], cp[8]; float hrun = 0.f, prun = 1.f;
#pragma unroll
    for (int i = 0; i < 8; ++i) { const int t = tq * 8 + i; const float r = sigmoid_f(PR[t * 64 + cch] + bac), ig = sigmoid_f(PR[4096 + t * 64 + cch] + bxc), log_a = -8.0f * r * spl;
        const float a = fexp(log_a), uu = fsqrt((1.0f - fexp(2.0f * log_a))) * (ig * xv[i]);
        hrun = a * hrun + uu; prun *= a; hl[i] = hrun; cp[i] = prun; }
    SEG[tq * 64 + cch] = prun; SEG[512 + tq * 64 + cch] = hrun;
    __syncthreads();
    { float carry = 0.f, pin = 1.f;
#pragma unroll
      for (int s = 0; s < 8; ++s) { const float ps = SEG[s * 64 + cch], hs = SEG[512 + s * 64 + cch]; if (s < tq) { carry = ps * carry + hs; pin *= ps; } }
#pragma unroll
      for (int i = 0; i < 8; ++i) { const int t = tq * 8 + i; const float h = hl[i] + cp[i] * carry, p = cp[i] * pin; HL[t * 64 + cch] = h; CP[t * 64 + cch] = p;
          if (t == 63) { TOT[cch] = p; TOT[64 + cch] = h; } } }
    __syncthreads();
}
__device__ __forceinline__ void lru_post_unit(unsigned char* ws, LAS unsigned char* lds, int u, int tid) {
    asm volatile("" : "+v"(tid));
    using namespace lr;
    const int c = u & 31, n = (u >> 5) & 7, b = u >> 8;
    const bf16* P = (const bf16*)(ws + WS_P); bf16* mix = (bf16*)(ws + WS_MIX0);
    const float* HL = (const float*)(ws + G_HL) + (size_t)u * 4096; const float* CP = (const float*)(ws + G_CP) + (size_t)u * 4096; const float* TOT = (const float*)(ws + G_TOT) + (size_t)(u - c) * 128;
    LAS float* TT = (LAS float*)lds; LAS float* CAR = TT + 32 * 128;
    for (int idx = tid; idx < c * 128; idx += 512) TT[idx] = TOT[idx];
    __syncthreads();
    if (tid < 64) { float carry = 0.f; for (int cc = 0; cc < c; ++cc) carry = TT[cc * 128 + tid] * carry + TT[cc * 128 + 64 + tid]; CAR[tid] = carry; }
    __syncthreads();
    const int cch = tid & 63, tq = tid >> 6, ch = n * 64 + cch; const float carry = CAR[cch];
#pragma unroll
    for (int i = 0; i < 8; ++i) { const int t = tq * 8 + i; const size_t m = (size_t)(b * T + c * 64 + t);
        const float h = HL[t * 64 + cch] + CP[t * 64 + cch] * carry; const float gt = bf2f(P[m * N_EIN + E_GATE + ch]);
        mix[m * D + 512 + ch] = (bf16)f2bf(h * gelu_tanh_f(gt)); }
    __syncthreads();
}

namespace sd {
constexpr int PQ = 72, PS = 136, RAWP = 320;
constexpr int L_RAW = 0, L_WM = 0, L_XSF = 43008, L_BN = L_XSF + 16384, L_CN = L_BN + 17408, L_HN = L_CN + 17408, L_BHT = L_HN + 17408, L_XDT = L_BHT + 18432, L_DT = L_XDT + 9216, L_ACS = L_DT + 256, L_END = L_ACS + 256;
static_assert(L_END <= LDS_BYTES - 2048, "ssd LDS");
}
__device__ __forceinline__ void ssd_chunk_item(const float* const* in, unsigned char* ws, LAS unsigned char* lds, int item, int tid) {
    asm volatile("" : "+v"(tid));
    using namespace sd;
    const int b = item >> 4, h = item & 15, g = h >> 3, lane = tid & 63, wave = tid >> 6;
    const bf16* P = (const bf16*)(ws + WS_P); bf16* ssdy = (bf16*)(ws + WS_SSDY);
    const float* conv_w = in[21]; const float* conv_b = in[22];
    const float dtb = in[23][h], a_h = -fexp(in[24][h]), dsk = in[25][h];
    LAS bf16* RAW = (LAS bf16*)(lds + L_RAW); LAS bf16* WM = (LAS bf16*)(lds + L_WM); LAS float* XSF = (LAS float*)(lds + L_XSF);
    LAS bf16* BN = (LAS bf16*)(lds + L_BN); LAS bf16* CN = (LAS bf16*)(lds + L_CN); LAS bf16* HN = (LAS bf16*)(lds + L_HN); LAS bf16* BHT = (LAS bf16*)(lds + L_BHT); LAS bf16* XDT = (LAS bf16*)(lds + L_XDT);
    LAS float* DT = (LAS float*)(lds + L_DT); LAS float* ACS = (LAS float*)(lds + L_ACS);
    const size_t rowbase = (size_t)b * T;
    v4u rr[6]; bf16 rdt = 0;
#define SSD_LOAD(t0_) do { _Pragma("unroll") for (int i = 0; i < 6; ++i) { const int id = tid + 512 * i; const int r = id / 40, cc = id - r * 40, tt = (t0_) - 3 + r; \
            const int col = cc < 8 ? O_XS + h * 64 + 8 * cc : (cc < 24 ? O_B + g * 128 + 8 * (cc - 8) : O_C + g * 128 + 8 * (cc - 24)); \
            rr[i] = (id < 67 * 40 && tt >= 0) ? *(const GAS v4u*)(P + (rowbase + tt) * N_OIN + col) : (v4u){0u, 0u, 0u, 0u}; } \
        if (tid < 64) rdt = P[(rowbase + (t0_) + tid) * N_OIN + O_DT + h]; } while (0)
    for (int i = tid; i < 64 * PS / 2; i += 512) ((LAS unsigned*)HN)[i] = 0u;
    f32x16 Hs;
#pragma unroll
    for (int r = 0; r < 16; ++r) Hs[r] = 0.f;
    const int sb = wave >> 1, pbk = wave & 1;
    const int xp = tid & 63, xseg = tid >> 6;
    const int bs = tid & 127, bseg = tid >> 7;
    const int chx = h * 64 + xp, chb = 1024 + g * 128 + bs, chc = 1280 + g * 128 + bs;
    const float xw0 = conv_w[chx], xw1 = conv_w[1536 + chx], xw2 = conv_w[3072 + chx], xw3 = conv_w[4608 + chx], xcb = conv_b[chx];
    const float bw0 = conv_w[chb], bw1 = conv_w[1536 + chb], bw2 = conv_w[3072 + chb], bw3 = conv_w[4608 + chb], bcb = conv_b[chb];
    const float cw0 = conv_w[chc], cw1 = conv_w[1536 + chc], cw2 = conv_w[3072 + chc], cw3 = conv_w[4608 + chc], ccb = conv_b[chc];
    SSD_LOAD(0);
    for (int c = 0; c < T / 64; ++c) {
        const int t0 = c * 64;
#pragma unroll
        for (int i = 0; i < 6; ++i) { const int id = tid + 512 * i; if (id < 67 * 40) { const int r = id / 40, cc = id - r * 40; *(LAS v4u*)(RAW + r * RAWP + 8 * cc) = rr[i]; } }
        if (tid < 64) { const float dt = softplus_f(bf2f(rdt) + dtb); float v = dt * a_h;
#pragma unroll
            for (int off = 1; off < 64; off <<= 1) { const float u = __shfl_up(v, off); if (lane >= off) v += u; }
            DT[tid] = dt; ACS[tid] = v; }
        __syncthreads();
        if (c + 1 < T / 64) SSD_LOAD(t0 + 64);
        const float acs_last = ACS[63];
        {
            float rw[11];
#pragma unroll
            for (int j = 0; j < 11; ++j) rw[j] = bf2f(RAW[(8 * xseg + j) * RAWP + xp]);
            unsigned pk[4];
#pragma unroll
            for (int i = 0; i < 8; i += 2) { const float x0 = silu_x(xcb + xw0 * rw[i] + xw1 * rw[i + 1] + xw2 * rw[i + 2] + xw3 * rw[i + 3]), x1 = silu_x(xcb + xw0 * rw[i + 1] + xw1 * rw[i + 2] + xw2 * rw[i + 3] + xw3 * rw[i + 4]);
                const int l = 8 * xseg + i; XSF[l * 64 + xp] = x0; XSF[(l + 1) * 64 + xp] = x1; pk[i >> 1] = pk2(x0 * DT[l], x1 * DT[l + 1]); }
            *(LAS v4u*)(XDT + xp * PQ + 8 * xseg) = (v4u){pk[0], pk[1], pk[2], pk[3]};
        }
        {
            float rw[19];
#pragma unroll
            for (int j = 0; j < 19; ++j) rw[j] = bf2f(RAW[(16 * bseg + j) * RAWP + 64 + bs]);
            unsigned pk[8];
#pragma unroll
            for (int i = 0; i < 16; i += 2) { const float v0 = silu_x(bcb + bw0 * rw[i] + bw1 * rw[i + 1] + bw2 * rw[i + 2] + bw3 * rw[i + 3]), v1 = silu_x(bcb + bw0 * rw[i + 1] + bw1 * rw[i + 2] + bw2 * rw[i + 3] + bw3 * rw[i + 4]);
                const int l = 16 * bseg + i; BN[l * PS + bs] = (bf16)f2bf(v0); BN[(l + 1) * PS + bs] = (bf16)f2bf(v1);
                pk[i >> 1] = pk2(v0 * fexp(acs_last - ACS[l]), v1 * fexp(acs_last - ACS[l + 1])); }
            *(LAS v4u*)(BHT + bs * PQ + 16 * bseg) = (v4u){pk[0], pk[1], pk[2], pk[3]}; *(LAS v4u*)(BHT + bs * PQ + 16 * bseg + 8) = (v4u){pk[4], pk[5], pk[6], pk[7]};
#pragma unroll
            for (int j = 0; j < 19; ++j) rw[j] = bf2f(RAW[(16 * bseg + j) * RAWP + 192 + bs]);
#pragma unroll
            for (int i = 0; i < 16; ++i) { const float v0 = silu_x(ccb + cw0 * rw[i] + cw1 * rw[i + 1] + cw2 * rw[i + 2] + cw3 * rw[i + 3]); CN[(16 * bseg + i) * PS + bs] = (bf16)f2bf(v0); }
        }
        __syncthreads();
        f32x16 yi;
#pragma unroll
        for (int r = 0; r < 16; ++r) yi[r] = 0.f;
        const int lb = (wave & 3) >> 1, qb = wave & 1;
        if (wave < 4) { mm32<128>(yi, CN, PS, 32 * lb, HN, PS, 32 * qb, lane);
#pragma unroll
            for (int r = 0; r < 16; ++r) yi[r] *= fexp(ACS[32 * lb + accrow(r, lane)]); }
        else { f32x16 a;
#pragma unroll
            for (int r = 0; r < 16; ++r) a[r] = 0.f;
            if (qb <= lb) mm32<128>(a, CN, PS, 32 * lb, BN, PS, 32 * qb, lane);
            const int mm = 32 * qb + (lane & 31); const float am = ACS[mm];
#pragma unroll
            for (int r = 0; r < 16; ++r) { const int ll = 32 * lb + accrow(r, lane); WM[ll * PQ + mm] = (bf16)f2bf(mm <= ll ? a[r] * fexp(ACS[ll] - am) : 0.f); } }
        __syncthreads();
        if (wave < 4) { mm32<64>(yi, WM, PQ, 32 * lb, XDT, PQ, 32 * qb, lane);
            const int pp = 32 * qb + (lane & 31);
#pragma unroll
            for (int r = 0; r < 16; ++r) { const int ll = 32 * lb + accrow(r, lane); ssdy[(rowbase + t0 + ll) * D + h * 64 + pp] = (bf16)f2bf(yi[r] + dsk * XSF[ll * 64 + pp]); } }
        { const float cd = fexp(acs_last);
#pragma unroll
          for (int r = 0; r < 16; ++r) Hs[r] *= cd;
          mm32<64>(Hs, BHT, PQ, 32 * sb, XDT, PQ, 32 * pbk, lane);
#pragma unroll
          for (int g4 = 0; g4 < 4; ++g4) { v2u w; w.x = pk2(Hs[4 * g4], Hs[4 * g4 + 1]); w.y = pk2(Hs[4 * g4 + 2], Hs[4 * g4 + 3]);
              *(LAS v2u*)(HN + (32 * pbk + (lane & 31)) * PS + 32 * sb + 8 * g4 + 4 * (lane >> 5)) = w; } }
        __syncthreads();
    }
#undef SSD_LOAD
}

namespace rw {
constexpr int TB = 32;
constexpr int O_AV = 0, O_WR = 8192, O_WV = 16384, O_BV = 24576, O_KV = 32768, O_VV = 40960, O_C12 = 45056, O_YB = 45312, BUF = 49408;
static_assert(2 * BUF <= LDS_BYTES - 2048, "rwkv LDS");
}
__device__ __forceinline__ float dpp_row16_sum(float v) {
    v += __builtin_bit_cast(float, __builtin_amdgcn_update_dpp(0, __builtin_bit_cast(int, v), 0xB1, 0xF, 0xF, true));
    v += __builtin_bit_cast(float, __builtin_amdgcn_update_dpp(0, __builtin_bit_cast(int, v), 0x4E, 0xF, 0xF, true));
    v += __builtin_bit_cast(float, __builtin_amdgcn_update_dpp(0, __builtin_bit_cast(int, v), 0x124, 0xF, 0xF, true));
    v += __builtin_bit_cast(float, __builtin_amdgcn_update_dpp(0, __builtin_bit_cast(int, v), 0x128, 0xF, 0xF, true));
    return v;
}
__device__ __forceinline__ f32x4 bf4_to_f32(v2u w) { return (f32x4){__uint_as_float(w.x << 16), __uint_as_float(w.x & 0xffff0000u), __uint_as_float(w.y << 16), __uint_as_float(w.y & 0xffff0000u)}; }
__device__ __forceinline__ void rwkv_scan_item(const float* const* in, unsigned char* ws, LAS unsigned char* lds, int item, int tid) {
    asm volatile("" : "+v"(tid));
    using namespace rw;
    const int b = item >> 4, h = (item >> 1) & 7, rh = item & 1, lane = tid & 63, wave = tid >> 6;
    const bf16* P = (const bf16*)(ws + WS_P); const float* mu = in[27];
    const float* DEC = (const float*)(ws + WS_DEC); const float* AA = (const float*)(ws + WS_AA);
    float* yraw = (float*)(ws + WS_YRAW); float* BS = (float*)(ws + WS_BS);
    const size_t rowbase = (size_t)b * T;
    const int st = 4 * wave + (lane >> 4), jq = lane & 15, hc4 = h * 64 + 4 * jq;
    const f32x4 mu_r = *(const GAS f32x4*)(mu + hc4), mu_k = *(const GAS f32x4*)(mu + 512 + hc4), mu_v = *(const GAS f32x4*)(mu + 1024 + hc4);
    const f32x4 kk_c = *(const GAS f32x4*)(in[33] + hc4), ka_c = *(const GAS f32x4*)(in[34] + hc4), rk_c = *(const GAS f32x4*)(in[35] + hc4);
    const int il = st, j = jq;
    v2u cr, ck, cv, pr_, pk_, pv_; f32x4 aa4, dd4;
#define RW_LOAD(blk_) do { const int tg = (blk_) * TB + st; const size_t m = rowbase + tg; const bf16* pr = P + m * N_OIN + O_R + hc4; const bf16* pp = (tg > 0) ? pr - N_OIN : pr; \
        cr = *(const GAS v2u*)(pr); ck = *(const GAS v2u*)(pr + 512); cv = *(const GAS v2u*)(pr + 1024); pr_ = *(const GAS v2u*)(pp); pk_ = *(const GAS v2u*)(pp + 512); pv_ = *(const GAS v2u*)(pp + 1024); \
        aa4 = *(const GAS f32x4*)(AA + m * 512 + hc4); dd4 = *(const GAS f32x4*)(DEC + m * 512 + hc4); } while (0)
#define RW_STAGE(blk_) do { LAS unsigned char* Bw = lds + ((blk_) & 1) * BUF; const int tg = (blk_) * TB + st; const size_t m = rowbase + tg; const float hp = tg > 0 ? 1.0f : 0.0f; \
        const f32x4 rc = bf4_to_f32(cr), kc = bf4_to_f32(ck), vc = bf4_to_f32(cv), rp = bf4_to_f32(pr_) * hp, kp = bf4_to_f32(pk_) * hp, vp = bf4_to_f32(pv_) * hp; \
        const f32x4 r_ = rc + (rp - rc) * mu_r, k_ = kc + (kp - kc) * mu_k, v_ = vc + (vp - vc) * mu_v, a_ = aa4, d_ = dd4; \
        const f32x4 kkr = k_ * kk_c; const float n2 = dpp_row16_sum((kkr.x * kkr.x + kkr.y * kkr.y) + (kkr.z * kkr.z + kkr.w * kkr.w)); \
        const f32x4 kk = kkr * frcp(fmaxf(fsqrt(n2), 1e-12f)); \
        const f32x4 k2 = k_ * ((a_ - 1.0f) * ka_c + 1.0f), bv = kk * a_, br = bv * r_, kr = k2 * r_, bb = kr * rk_c; \
        *(LAS f32x4*)(Bw + O_AV + (st * 64 + 4 * jq) * 4) = -kk; *(LAS f32x4*)(Bw + O_WR + (st * 64 + 4 * jq) * 4) = d_ * r_; *(LAS f32x4*)(Bw + O_WV + (st * 64 + 4 * jq) * 4) = d_; \
        *(LAS f32x4*)(Bw + O_BV + (st * 64 + 4 * jq) * 4) = bv; *(LAS f32x4*)(Bw + O_KV + (st * 64 + 4 * jq) * 4) = k2; \
        if ((jq >> 3) == rh) *(LAS f32x4*)(Bw + O_VV + (st * 32 + 4 * (jq & 7)) * 4) = v_; \
        const float c1 = dpp_row16_sum((br.x + br.y) + (br.z + br.w)), c2 = dpp_row16_sum((kr.x + kr.y) + (kr.z + kr.w)), bsum = dpp_row16_sum((bb.x + bb.y) + (bb.z + bb.w)); \
        if (jq == 0) { *(LAS float*)(Bw + O_C12 + 8 * st) = c1; *(LAS float*)(Bw + O_C12 + 8 * st + 4) = c2; if (rh == 0) BS[m * 8 + h] = bsum; } } while (0)
    f32x4 S = (f32x4){0.f, 0.f, 0.f, 0.f};
    RW_LOAD(0); RW_STAGE(0); RW_LOAD(1);
    __syncthreads();
    for (int blk = 0; blk < T / TB; ++blk) {
        if (blk + 1 < T / TB) { RW_STAGE(blk + 1); if (blk + 2 < T / TB) RW_LOAD(blk + 2); }
        const LAS unsigned char* B = lds + (blk & 1) * BUF;
        const LAS float* AV = (const LAS float*)(B + O_AV); const LAS float* WR = (const LAS float*)(B + O_WR); const LAS float* WV = (const LAS float*)(B + O_WV); const LAS float* BV = (const LAS float*)(B + O_BV); const LAS float* KV = (const LAS float*)(B + O_KV);
        const LAS float* VV = (const LAS float*)(B + O_VV); const LAS float* C12 = (const LAS float*)(B + O_C12); LAS float* YB = (LAS float*)(lds + (blk & 1) * BUF + O_YB);
        f32x4 a4 = *(const LAS f32x4*)(AV + 4 * j), wr4 = *(const LAS f32x4*)(WR + 4 * j), w4 = *(const LAS f32x4*)(WV + 4 * j), b4 = *(const LAS f32x4*)(BV + 4 * j), k4 = *(const LAS f32x4*)(KV + 4 * j);
        float vv = VV[il]; float c1 = C12[0], c2 = C12[1];
#pragma unroll 4
        for (int t = 0; t < TB; ++t) {
            const int tn = (t + 1 < TB) ? t + 1 : t;
            const f32x4 na4 = *(const LAS f32x4*)(AV + tn * 64 + 4 * j), nwr4 = *(const LAS f32x4*)(WR + tn * 64 + 4 * j), nw4 = *(const LAS f32x4*)(WV + tn * 64 + 4 * j), nb4 = *(const LAS f32x4*)(BV + tn * 64 + 4 * j), nk4 = *(const LAS f32x4*)(KV + tn * 64 + 4 * j);
            const float nvv = VV[tn * 32 + il], nc1 = C12[2 * tn], nc2 = C12[2 * tn + 1];
            float psa = (S.x * a4.x + S.y * a4.y) + (S.z * a4.z + S.w * a4.w);
            float py = (S.x * wr4.x + S.y * wr4.y) + (S.z * wr4.z + S.w * wr4.w);
            const f32x4 tmp = S * w4 + k4 * vv;
            psa = dpp_row16_sum(psa); py = dpp_row16_sum(py);
            S = tmp + b4 * psa;
            const float y = py + psa * c1 + vv * c2;
            YB[t * 32 + il] = y;
            a4 = na4; wr4 = nwr4; w4 = nw4; b4 = nb4; k4 = nk4; vv = nvv; c1 = nc1; c2 = nc2;
        }
        if (blk > 0) {
            const LAS float* YP = (const LAS float*)(lds + ((blk - 1) & 1) * BUF + O_YB); const int t = tid >> 4, ii = (tid & 15) * 2;
            float2 v; v.x = YP[t * 32 + ii]; v.y = YP[t * 32 + ii + 1]; *(float2*)(yraw + (rowbase + (blk - 1) * TB + t) * 512 + h * 64 + 32 * rh + ii) = v; }
        __syncthreads();
    }
    { const LAS float* YP = (const LAS float*)(lds + ((T / TB - 1) & 1) * BUF + O_YB); const int t = tid >> 4, ii = (tid & 15) * 2;
      float2 v; v.x = YP[t * 32 + ii]; v.y = YP[t * 32 + ii + 1]; *(float2*)(yraw + (rowbase + (T / TB - 1) * TB + t) * 512 + h * 64 + 32 * rh + ii) = v; }
    __syncthreads();
#undef RW_LOAD
#undef RW_STAGE
}
__device__ __forceinline__ void mix1_rows(const float* const* in, unsigned char* ws, int gw, int NGW, int lane) {
    ssd_norm_rows(in, ws, gw, NGW, lane);
    const bf16* P = (const bf16*)(ws + WS_P); const float* mu = in[27]; bf16* mix = (bf16*)(ws + WS_MIX1);
    const float* yraw = (const float*)(ws + WS_YRAW); const float* BS = (const float*)(ws + WS_BS); const bf16* GG = (const bf16*)(ws + WS_GG);
    for (int m = gw; m < M; m += NGW) {
        const bool hp = (m % T) != 0;
#pragma unroll 2
        for (int hh = 0; hh < 8; ++hh) { const int hc = hh * 64 + lane;
            const float y = yraw[(size_t)m * 512 + hc]; const float mean = wave_sum(y) * (1.0f / 64.0f); const float dv = y - mean; const float var = wave_sum(dv * dv) * (1.0f / 64.0f);
            const float yn = dv * (frsq(var + 64e-5f)) * in[36][hc] + in[37][hc];
            const float vc = bf2f(P[(size_t)m * N_OIN + O_R + 1024 + hc]), vp = hp ? bf2f(P[(size_t)(m - 1) * N_OIN + O_R + 1024 + hc]) : 0.f; const float v_ = vc + (vp - vc) * mu[1024 + hc];
            mix[(size_t)m * K_OOUT + 1024 + hc] = (bf16)f2bf((yn + BS[(size_t)m * 8 + hh] * v_) * bf2f(GG[(size_t)m * 512 + hc])); }
    }
}

template <int K>
__device__ __forceinline__ void mm32g(f32x16& acc, const LAS bf16* A, int pa, int arow0, const bf16* Btg, int brow0, int lane) {
    const LAS bf16* ap = A + (arow0 + (lane & 31)) * pa + 8 * (lane >> 5); const bf16* bp = Btg + (size_t)(brow0 + (lane & 31)) * K + 8 * (lane >> 5);
    bf16x8_t bfr[K / 16];
#pragma unroll
    for (int ks = 0; ks < K / 16; ++ks) bfr[ks] = *(const GAS bf16x8_t*)(bp + 16 * ks);
#pragma unroll
    for (int ks = 0; ks < K / 16; ++ks) { const bf16x8_t a = *(const LAS bf16x8_t*)(ap + 16 * ks); acc = __builtin_amdgcn_mfma_f32_32x32x16_bf16(a, bfr[ks], acc, 0, 0, 0); }
}
__device__ __forceinline__ void rwkv_pre_mfma(const float* const* in, unsigned char* ws, LAS unsigned char* lds, int tile, int tid) {
    asm volatile("" : "+v"(tid));
    const int lane = tid & 63, wave = tid >> 6;
    const bf16* P = (const bf16*)(ws + WS_P); const float* mu = in[27];
    float* DEC = (float*)(ws + WS_DEC); float* AA = (float*)(ws + WS_AA); bf16* GG = (bf16*)(ws + WS_GG);
    LAS bf16* TW = (LAS bf16*)lds; LAS bf16* XA = TW + 64 * 72; LAS bf16* SG = XA + 64 * 72;
    const int m0 = tile * 64;
#pragma unroll
    for (int ps = 0; ps < 4; ++ps) { const int id = tid + 512 * ps, t = id >> 5, c8 = (id & 31) * 8, m = m0 + t;
        const v4u cur = *(const GAS v4u*)(P + (size_t)m * N_OIN + O_R + 1536 + c8); const v4u prv = (m % T) ? *(const GAS v4u*)(P + (size_t)(m - 1) * N_OIN + O_R + 1536 + c8) : (v4u){0u, 0u, 0u, 0u};
        const f32x4 mu0 = *(const GAS f32x4*)(mu + 1536 + c8), mu1 = *(const GAS f32x4*)(mu + 1536 + c8 + 4);
        const f32x4 c0 = bf4_to_f32((v2u){cur.x, cur.y}), c1 = bf4_to_f32((v2u){cur.z, cur.w}), p0 = bf4_to_f32((v2u){prv.x, prv.y}), p1 = bf4_to_f32((v2u){prv.z, prv.w});
        const f32x4 x0 = c0 + (p0 - c0) * mu0, x1 = c1 + (p1 - c1) * mu1; float o[8] = {x0.x, x0.y, x0.z, x0.w, x1.x, x1.y, x1.z, x1.w};
        if (c8 < 64) {
#pragma unroll
            for (int i = 0; i < 8; ++i) o[i] = tanh_f(o[i]);
        } else if (c8 >= 128) {
#pragma unroll
            for (int i = 0; i < 8; ++i) o[i] = sigmoid_f(o[i]);
        }
        const v4u w = (v4u){pk2(o[0], o[1]), pk2(o[2], o[3]), pk2(o[4], o[5]), pk2(o[6], o[7])};
        if (c8 < 64) *(LAS v4u*)(TW + t * 72 + c8) = w; else if (c8 < 128) *(LAS v4u*)(XA + t * 72 + (c8 - 64)) = w; else *(LAS v4u*)(SG + t * 136 + (c8 - 128)) = w; }
    __syncthreads();
    const bf16* W2T = (const bf16*)(ws + WS_LW2); const bf16* A2T = (const bf16*)(ws + WS_LA2); const bf16* G2T = (const bf16*)(ws + WS_LG2);
#pragma unroll 1
    for (int q = 0; q < 4; ++q) { const int tb = q >> 1, jb = 64 * wave + 32 * (q & 1), j = jb + (lane & 31);
        f32x16 acc;
#pragma unroll
        for (int r = 0; r < 16; ++r) acc[r] = 0.f;
        mm32g<64>(acc, TW, 72, 32 * tb, W2T, jb, lane);
        { const float w0j = in[28][j];
#pragma unroll
          for (int r = 0; r < 16; ++r) { const float wl = -softplus_f(-(w0j + acc[r])) - 0.5f; DEC[(size_t)(m0 + 32 * tb + accrow(r, lane)) * 512 + j] = fexp(-fexp(wl)); acc[r] = 0.f; } }
        mm32g<64>(acc, XA, 72, 32 * tb, A2T, jb, lane);
        { const float a0j = in[30][j];
#pragma unroll
          for (int r = 0; r < 16; ++r) { AA[(size_t)(m0 + 32 * tb + accrow(r, lane)) * 512 + j] = sigmoid_f(a0j + acc[r]); acc[r] = 0.f; } }
        mm32g<128>(acc, SG, 136, 32 * tb, G2T, jb, lane);
#pragma unroll
        for (int r = 0; r < 16; ++r) GG[(size_t)(m0 + 32 * tb + accrow(r, lane)) * 512 + j] = (bf16)f2bf(acc[r]); }
    __syncthreads();
}

struct Args { const float* in[47]; float* out; unsigned char* ws; };
__global__ void __launch_bounds__(NWAVES * 64, 2) fwd_kernel(Args args) {
    extern __shared__ __attribute__((aligned(16))) unsigned char lds_raw[];
    LAS unsigned char* lds = (LAS unsigned char*)lds_raw;
    volatile LAS unsigned* MISC = (volatile LAS unsigned*)(lds + MISC_OFF);
    LAS int* PE = (LAS int*)(lds + PE_OFF);
    LAS float* Lf = (LAS float*)(lds + RING_OFF);
    const int tid = threadIdx.x, lane = tid & 63, wave = __builtin_amdgcn_readfirstlane(tid >> 6);
    const int G = gridDim.x, bid = blockIdx.x, gw = bid * NWAVES + wave, NGW = G * NWAVES;
    unsigned char* ws = args.ws; const float* const* in = args.in;
    gu32* ctl = (gu32*)(ws + WS_CTL);
    for (int u = tid; u < (LDS_BYTES - LDSCTL_OFF) / 4; u += NWAVES * 64) ((LAS unsigned*)(lds + LDSCTL_OFF))[u] = 0u;
    __syncthreads();
    XcdBarrier bar = xcd_barrier_post((unsigned*)(ctl + CW_BAR), MISC + 8);
#define GRID_BAR() xcd_barrier(bar)
    bf16* XBF = (bf16*)(ws + WS_XBF); bf16* PB = (bf16*)(ws + WS_P); float* Y = (float*)(ws + WS_Y);

#if !defined(ONLY) || ONLY==0
    {
    {
        LAS float* scr = Lf + wave * (64 * 33);
        for (int it = gw; it < IT_SMALL; it += NGW) cvt_small_item(in, ws, it, scr, lane);
        bf16* WE = (bf16*)(ws + WS_WEIN);
        for (int idx = bid * 512 + tid; idx < 256 * 1024; idx += G * 512) { const int k = idx & 1023, n = idx >> 10; float s = 0.f;
#pragma unroll
            for (int r = 0; r < 16; ++r) s += in[1][(size_t)k * 2576 + 1536 + r] * in[2][r * 256 + n];
            WE[(size_t)(E_GK + n) * D + k] = (bf16)f2bf(s); }
        for (size_t idx = (size_t)bid * 512 + tid; idx < (size_t)M * D / 4; idx += (size_t)G * 512) { const f32x4 v = ((const GAS f32x4*)in[0])[idx]; v2u o; o.x = pk2(v.x, v.y); o.y = pk2(v.z, v.w); ((GAS v2u*)XBF)[idx] = o; }
    }
    GRID_BAR();
    }
#endif
#if !defined(ONLY) || ONLY==1
    {
    { pg8::Gemm g{XBF, (const bf16*)(ws + WS_WEIN), M, N_EIN, D}; pg8::StaticOrder S; S.init(M, N_EIN, G, bid); pg8::EpiStoreBf16 E{PB, N_EIN};
      pg8::gemm_phase<pg8::EpiStoreBf16, pg8::StaticOrder, true, true>(lds + RING_OFF, g, S, E); }
    GRID_BAR();
    }
#endif
#if !defined(ONLY) || ONLY==2
    {
    for (int u = bid; u < 1024; u += G) gla_pre_unit(in, ws, lds, u, tid);
    for (int u = bid; u < 2048; u += G) lru_pre_unit(in, ws, lds, u, tid, u == bid);
    GRID_BAR();
    }
#endif
#if !defined(ONLY) || ONLY==21
    {
    if (bid < 32) gla_mid_item(ws, lds, bid, tid);
    else { for (int u = bid - 32; u < 2048; u += G - 32) lru_post_unit(ws, lds, u, tid); }
    GRID_BAR();
    }
#endif
#if !defined(ONLY) || ONLY==22
    {
    for (int u = bid; u < 1024; u += G) gla_post_unit(in, ws, lds, u, tid);
    GRID_BAR();
    }
#endif
#if !defined(ONLY) || ONLY==3
    {
    { pg8::Gemm g{(const bf16*)(ws + WS_MIX0), (const bf16*)(ws + WS_WEOUT), M, D, D}; pg8::StaticOrder S; S.init(M, D, G, bid); pg8::EpiStoreF32 E{Y, D};
      pg8::gemm_phase<pg8::EpiStoreF32, pg8::StaticOrder, true, true>(lds + RING_OFF, g, S, E); }
    GRID_BAR();
    }
#endif
#if !defined(ONLY) || ONLY==4
    {
    ln_rows<0>(in[0], Y, in[13], in[14], args.out, XBF, nullptr, ws, ctl, gw, NGW, lane);
    GRID_BAR();
    }
#endif
#if !defined(ONLY) || ONLY==5
    {
    { pg8::Gemm g{XBF, (const bf16*)(ws + WS_WF13), M, N_F13, D}; pg8::StaticOrder S; S.init(M, N_F13, G, bid); pg8::EpiSwiGLU E{PB, FF};
      pg8::gemm_phase<pg8::EpiSwiGLU, pg8::StaticOrder, true, true>(lds + RING_OFF, g, S, E); }
    GRID_BAR();
    }
#endif
#if !defined(ONLY) || ONLY==6
    {
    { pg8::Gemm g{PB, (const bf16*)(ws + WS_WF2), M, D, FF}; pg8::StaticOrder S; S.init(M, D, G, bid); pg8::EpiStoreF32 E{Y, D};
      pg8::gemm_phase<pg8::EpiStoreF32, pg8::StaticOrder, true, true>(lds + RING_OFF, g, S, E); }
    GRID_BAR();
    }
#endif
#if !defined(ONLY) || ONLY==7
    {
    ln_rows<0>(args.out, Y, in[18], in[19], args.out, XBF, nullptr, ws, ctl, gw, NGW, lane);
    GRID_BAR();
    }
#endif
#if !defined(ONLY) || ONLY==8
    {
    { pg8::Gemm g{XBF, (const bf16*)(ws + WS_WOIN), M, N_OIN, D}; pg8::StaticOrder S; S.init(M, N_OIN, G, bid); pg8::EpiStoreBf16 E{PB, N_OIN};
      pg8::gemm_phase<pg8::EpiStoreBf16, pg8::StaticOrder, true, true>(lds + RING_OFF, g, S, E); }
    GRID_BAR();
    }
#endif
#if !defined(ONLY) || ONLY==9
    {
    for (int tl = bid; tl < 256; tl += G) rwkv_pre_mfma(in, ws, lds, tl, tid);
    GRID_BAR();
    }
#endif
#if !defined(ONLY) || ONLY==10
    {
    if (bid < 128) { ssd_chunk_item(in, ws, lds, bid, tid);
        LAS float* scr = Lf + wave * (64 * 33);
        for (int it = bid * NWAVES + wave; it < IT_E13; it += 128 * NWAVES) cvt_exp_item(in, ws, it, scr, lane); }
    else rwkv_scan_item(in, ws, lds, bid - 128, tid);
    GRID_BAR();
    mix1_rows(in, ws, gw, NGW, lane);
    GRID_BAR();
    }
#endif
#if !defined(ONLY) || ONLY==11
    {
    { pg8::Gemm g{(const bf16*)(ws + WS_MIX1), (const bf16*)(ws + WS_WOOUT), M, D, K_OOUT}; pg8::StaticOrder S; S.init(M, D, G, bid); pg8::EpiStoreF32 E{Y, D};
      pg8::gemm_phase<pg8::EpiStoreF32, pg8::StaticOrder, true, true>(lds + RING_OFF, g, S, E); }
    { LAS float* scr = Lf + wave * (64 * 33);
      for (int it = IT_E13 + gw; it < IT_EXP; it += NGW) cvt_exp_item(in, ws, it, scr, lane); }
    GRID_BAR();
    }
#endif
#if !defined(ONLY) || ONLY==12
    {
    ln_rows<1>(args.out, Y, in[39], in[40], args.out, XBF, in[41], ws, ctl, gw, NGW, lane);
    GRID_BAR();
    }
#endif
#if !defined(ONLY) || ONLY==13
    {
    {
        if (tid == 0) { int off = 0;
            for (int e = 0; e < NE; ++e) { const int c = (int)__hip_atomic_load(ctl + CW_CNT + 64 * e, RLX_AGENT); const int np = (c + 255) >> 8; PE[160 + e] = off; for (int p = off; p < off + np && p < 160; ++p) PE[p] = e; off += np; }
            PE[168] = off; PE[169] = off; for (int p = off; p < 160; ++p) PE[p] = 0; }
        __syncthreads();
        const int* re = (const int*)(ws + WS_ROUTE + RT_E); const int* rp = (const int*)(ws + WS_ROUTE + RT_P); int* rdst = (int*)(ws + WS_ROUTE + RT_DST); bf16* XY = (bf16*)(ws + WS_XY);
        for (int pr = gw; pr < 2 * M; pr += NGW) { const int e = re[pr], dst = PE[160 + e] * 256 + rp[pr]; const int m = pr >> 1;
            const GAS v4u* src = (const GAS v4u*)(XBF + (size_t)m * D) + lane; GAS v4u* dp = (GAS v4u*)(XY + (size_t)dst * D) + lane;
            dp[0] = src[0]; dp[64] = src[64]; if (lane == 0) rdst[pr] = dst; }
        for (int e = 0; e < NE; ++e) { const int c = (int)__hip_atomic_load(ctl + CW_CNT + 64 * e, RLX_AGENT); const int r0 = PE[160 + e] * 256 + c, r1 = PE[160 + e] * 256 + (((c + 255) >> 8) << 8);
            for (int r = r0 + gw; r < r1; r += NGW) { GAS v4u* dp = (GAS v4u*)(XY + (size_t)r * D) + lane; dp[0] = (v4u){0u, 0u, 0u, 0u}; dp[64] = (v4u){0u, 0u, 0u, 0u}; } }
    }
    GRID_BAR();
    }
#endif
#ifndef NO_MOE
#if !defined(ONLY) || ONLY==14
    {
    {
        const int NP = PE[169]; const int nchunks = (NP + MOE_CP - 1) / MOE_CP;
        for (int c = 0; c <= nchunks; ++c) {
            const int np_up = c < nchunks ? min(MOE_CP, NP - c * MOE_CP) : 0, np_dn = c > 0 ? min(MOE_CP, NP - (c - 1) * MOE_CP) : 0;
            const int nu = np_up * 28, nd = np_dn * 4;
            int Lv = (7 * nd + 2 * nu + G - 1) / G; if (Lv < 0) Lv = 0;
            for (;;) { const int qa_ = Lv > 7 ? (Lv - 7) / 2 : 0, qb_ = Lv / 2; if ((long)nd * qa_ + (long)(G - nd) * qb_ >= nu) break; ++Lv; }
            const int qa = Lv > 7 ? (Lv - 7) / 2 : 0, qb = Lv / 2;
            const int ndc = nd < G ? nd : G;
            const int ustart = bid < ndc ? bid * qa : ndc * qa + (bid - ndc) * qb; int ucount = bid < ndc ? qa : qb; if (ustart + ucount > nu) ucount = nu - ustart; if (ucount < 0) ucount = 0;
            bf16* HEup = (bf16*)(ws + WS_HE + (size_t)(c & 1) * HE_BYTES); const bf16* HEdn = (const bf16*)(ws + WS_HE + (size_t)((c + 1) & 1) * HE_BYTES);
            if (nd > 0) { pg8::Gemm g{HEdn, (const bf16*)(ws + WS_EXP2), 0, D, FE}; pg8::MoeDownOrder S{bid, 0, (c - 1) * MOE_CP, PE};
                int cnt = 0; for (int d = bid; d < nd; d += G) ++cnt; S.count = cnt;
                pg8::EpiStoreBf16 E{(bf16*)(ws + WS_XY), D};
                pg8::gemm_phase<pg8::EpiStoreBf16, pg8::MoeDownOrder, true, true>(lds + RING_OFF, g, S, E); }
            if (nu > 0) { pg8::Gemm g{(const bf16*)(ws + WS_XY), (const bf16*)(ws + WS_EXP13), 0, N_E13, D}; pg8::MoeUpOrder S{ustart, ucount, c * MOE_CP, PE};
                pg8::EpiSwiGLU E{HEup, FE};
                pg8::gemm_phase<pg8::EpiSwiGLU, pg8::MoeUpOrder, true, true>(lds + RING_OFF, g, S, E); }
            GRID_BAR();
        }
    }
    }
#endif
#endif
    ln_rows<2>(args.out, nullptr, in[45], in[46], args.out, nullptr, nullptr, ws, ctl, gw, NGW, lane);
}

extern "C" void kernel_launch(void* const* d_in, const int* in_sizes, int n_in, void* d_out, int out_size, void* d_ws, size_t ws_size, hipStream_t stream) {
    static int grid = 0;
    if (grid == 0) {
        if (n_in != 47 || in_sizes[0] != M * D || out_size != M * D || ws_size < WS_END) { fprintf(stderr, "kernel_launch: unexpected shapes (n_in %d, out %d, ws %zu)\n", n_in, out_size, ws_size); grid = -1; return; }
        int dev = 0, cus = 0, per_cu = 0;
        if (hipGetDevice(&dev) != hipSuccess || hipDeviceGetAttribute(&cus, hipDeviceAttributeMultiprocessorCount, dev) != hipSuccess) { grid = -1; return; }
        if (hipFuncSetAttribute((const void*)fwd_kernel, hipFuncAttributeMaxDynamicSharedMemorySize, LDS_BYTES) != hipSuccess) { fprintf(stderr, "kernel_launch: hipFuncSetAttribute failed\n"); grid = -1; return; }
        if (hipOccupancyMaxActiveBlocksPerMultiprocessor(&per_cu, (const void*)fwd_kernel, NWAVES * 64, LDS_BYTES) != hipSuccess || per_cu < 1) { fprintf(stderr, "kernel_launch: occupancy query reports %d\n", per_cu); }
        (void)hipGetLastError();
        if (cus < 256) { fprintf(stderr, "kernel_launch: built for a 256-CU device, found %d CUs\n", cus); grid = -1; return; }
        grid = 256;
    }
    if (grid < 0) return;
    if (hipMemsetAsync((char*)d_ws + WS_CTL, 0, CTL_ZERO_BYTES, stream) != hipSuccess) return;
    Args a{};
    for (int i = 0; i < 47; ++i) a.in[i] = (const float*)d_in[i];
    a.out = (float*)d_out; a.ws = (unsigned char*)d_ws;
    hipLaunchKernelGGL(fwd_kernel, dim3(grid), dim3(NWAVES * 64), LDS_BYTES, stream, a);
}
```
